# Optimizing an MI355X kernel written in HIP

```python
import jax, jax.numpy as jnp
from jax import lax
import numpy as np

D_MODEL = 2048
BATCH = 2
SEQ = 4096
DEPTH = 1

CHUNK = 64
Q_BLOCK = 128
PLE_DIM = 256
EPS = 1e-6
MASK_VALUE = -1e30

MLA_HEADS = 8
QK_NOPE = 128
QK_ROPE = 64
QK_HEAD = QK_NOPE + QK_ROPE
V_HEAD = 128
Q_RANK = 512
KV_RANK = 256
ROPE_BASE = 10000.0
D_ATTN = MLA_HEADS * V_HEAD

D_CONV = D_MODEL // 2
CONV_WIDTH = 3

D_MIX = D_ATTN + D_CONV
D_IN = Q_RANK + KV_RANK + QK_ROPE + 3 * D_CONV

N_GROUPS = 4
EXPERTS_PER_GROUP = 8
N_EXPERTS = N_GROUPS * EXPERTS_PER_GROUP
TOP_K = 2
D_EXPERT = 512

kernel_name = "hybrid_mla_shortconv_hmoe_ple"


def rms_norm(x, g):
    xf = x.astype(jnp.float32)
    y = xf * lax.rsqrt(jnp.mean(xf * xf, axis=-1, keepdims=True) + EPS)
    return (y * g.astype(jnp.float32)).astype(x.dtype)


def rope_tables(positions, dtype):
    freq = ROPE_BASE ** (-jnp.arange(0, QK_ROPE, 2, dtype=jnp.float32) / QK_ROPE)
    ang = positions.astype(jnp.float32)[..., None] * freq
    return jnp.cos(ang).astype(dtype), jnp.sin(ang).astype(dtype)


def apply_rope(x, cos, sin):
    half = x.shape[-1] // 2
    x1, x2 = x[..., :half], x[..., half:]
    return jnp.concatenate([x1 * cos - x2 * sin, x2 * cos + x1 * sin], axis=-1)


def mla_mixer(q_lat, kv_lat, k_rope, positions, g_q_lat, g_kv_lat, w_uq, w_ukv, g_q_head, g_k_head):
    B, S, _ = q_lat.shape
    H = MLA_HEADS
    q = jnp.einsum('bsr,rhd->bshd', rms_norm(q_lat, g_q_lat), w_uq)
    kv = jnp.einsum('bsr,rhd->bshd', rms_norm(kv_lat, g_kv_lat), w_ukv)
    k_nope, v = kv[..., :QK_NOPE], kv[..., QK_NOPE:]
    k = jnp.concatenate([k_nope, jnp.broadcast_to(k_rope[:, :, None, :], (B, S, H, QK_ROPE))], axis=-1)
    q = rms_norm(q, g_q_head)
    k = rms_norm(k, g_k_head)
    cos, sin = rope_tables(positions, q.dtype)
    cos, sin = cos[:, :, None, :], sin[:, :, None, :]
    q = jnp.concatenate([q[..., :QK_NOPE], apply_rope(q[..., QK_NOPE:], cos, sin)], axis=-1)
    k = jnp.concatenate([k[..., :QK_NOPE], apply_rope(k[..., QK_NOPE:], cos, sin)], axis=-1)

    nb = S // Q_BLOCK
    qb = q.reshape(B, nb, Q_BLOCK, H, QK_HEAD).transpose(1, 0, 3, 2, 4)
    kT = k.transpose(0, 2, 1, 3)
    vT = v.transpose(0, 2, 1, 3)
    key_chunk = jnp.arange(S) // CHUNK
    scale = QK_HEAD ** -0.5

    def attend_block(args):
        qi, i = args
        s = jnp.einsum('bhqd,bhkd->bhqk', qi, kT).astype(jnp.float32) * scale
        q_chunk = (i * Q_BLOCK + jnp.arange(Q_BLOCK)) // CHUNK
        mask = key_chunk[None, :] <= q_chunk[:, None]
        s = jnp.where(mask, s, MASK_VALUE)
        pr = jax.nn.softmax(s, axis=-1).astype(vT.dtype)
        return jnp.einsum('bhqk,bhkd->bhqd', pr, vT)

    out = lax.map(attend_block, (qb, jnp.arange(nb)))
    return out.transpose(1, 0, 3, 2, 4).reshape(B, S, D_ATTN)


def short_conv_mixer(b_gate, c_gate, h, w_conv):
    S = h.shape[1]
    u = c_gate * h
    u_pad = jnp.pad(u, ((0, 0), (CONV_WIDTH - 1, 0), (0, 0)))
    conv = sum(u_pad[:, j:j + S] * w_conv[j] for j in range(CONV_WIDTH))
    return b_gate * conv


def hier_moe(x, w_group, b_group, w_router, b_router, w1, w3, w2):
    B, S, D = x.shape
    t = x.reshape(-1, D)
    T = t.shape[0]
    g_logits = (t @ w_group + b_group).astype(jnp.float32)
    g_prob = jax.nn.softmax(g_logits, axis=-1)
    g_sel = jnp.argmax(g_logits, axis=-1)
    p_g = jnp.take_along_axis(g_prob, g_sel[:, None], axis=-1)
    e_logits = (t @ w_router + b_router).astype(jnp.float32).reshape(T, N_GROUPS, EXPERTS_PER_GROUP)
    idx = jnp.broadcast_to(g_sel[:, None, None], (T, 1, EXPERTS_PER_GROUP))
    e_in_group = jnp.take_along_axis(e_logits, idx, axis=1)[:, 0]
    top_vals, top_idx = lax.top_k(e_in_group, TOP_K)
    w_top = jax.nn.softmax(top_vals, axis=-1) * p_g
    expert_id = g_sel[:, None] * EXPERTS_PER_GROUP + top_idx
    combine = jnp.sum(jax.nn.one_hot(expert_id, N_EXPERTS, dtype=jnp.float32) * w_top[..., None], axis=1)

    def expert_step(acc, params):
        w1e, w3e, w2e, ce = params
        hid = jax.nn.silu(t @ w1e) * (t @ w3e)
        return acc + ce[:, None].astype(t.dtype) * (hid @ w2e), None

    y, _ = lax.scan(expert_step, jnp.zeros_like(t), (w1, w3, w2, combine.T))
    return y.reshape(B, S, D)


def setup_inputs(seed: int = 0) -> dict:
    key = jax.random.key(seed)
    ks = jax.random.split(key, 32)
    f32 = jnp.float32

    def nrm(k, shape, fan_in):
        return jax.random.normal(k, shape, f32) * (fan_in ** -0.5)

    def gain(k, shape):
        return 1.0 + 0.01 * jax.random.normal(k, shape, f32)

    L = DEPTH
    x = jax.random.normal(ks[0], (BATCH, SEQ, D_MODEL), f32)
    p = jax.random.normal(ks[1], (DEPTH, BATCH, SEQ, PLE_DIM), f32)
    offsets = jax.random.randint(ks[2], (BATCH, 1), 0, 65536, dtype=jnp.int32)
    positions = offsets + jnp.arange(SEQ, dtype=jnp.int32)[None, :]
    return {
        "x": x,
        "p": p,
        "positions": positions,
        "norm_mix": gain(ks[3], (L, D_MODEL)),
        "w_in": nrm(ks[4], (L, D_MODEL, D_IN), D_MODEL),
        "g_q_lat": gain(ks[5], (L, Q_RANK)),
        "g_kv_lat": gain(ks[6], (L, KV_RANK)),
        "w_uq": nrm(ks[7], (L, Q_RANK, MLA_HEADS, QK_HEAD), Q_RANK),
        "w_ukv": nrm(ks[8], (L, KV_RANK, MLA_HEADS, QK_NOPE + V_HEAD), KV_RANK),
        "g_q_head": gain(ks[9], (L, QK_HEAD)),
        "g_k_head": gain(ks[10], (L, QK_HEAD)),
        "w_conv": nrm(ks[11], (L, CONV_WIDTH, D_CONV), CONV_WIDTH),
        "g_out_attn": gain(ks[12], (L, D_ATTN)),
        "g_out_conv": gain(ks[13], (L, D_CONV)),
        "w_out": nrm(ks[14], (L, D_MIX, D_MODEL), D_MIX),
        "norm_moe": gain(ks[15], (L, D_MODEL)),
        "w_group": nrm(ks[16], (L, D_MODEL, N_GROUPS), D_MODEL),
        "b_group": 0.01 * jax.random.normal(ks[17], (L, N_GROUPS), f32),
        "w_router": nrm(ks[18], (L, D_MODEL, N_EXPERTS), D_MODEL),
        "b_router": 0.01 * jax.random.normal(ks[19], (L, N_EXPERTS), f32),
        "w1": nrm(ks[20], (L, N_EXPERTS, D_MODEL, D_EXPERT), D_MODEL),
        "w3": nrm(ks[21], (L, N_EXPERTS, D_MODEL, D_EXPERT), D_MODEL),
        "w2": nrm(ks[22], (L, N_EXPERTS, D_EXPERT, D_MODEL), D_EXPERT),
        "norm_ple": gain(ks[23], (L, D_MODEL)),
        "w_ple": nrm(ks[24], (L, PLE_DIM, D_MODEL), PLE_DIM),
        "w_ple_gate": nrm(ks[25], (L, D_MODEL, D_MODEL), D_MODEL),
        "b_ple_gate": 0.01 * jax.random.normal(ks[26], (L, D_MODEL), f32),
    }


def reference(x, p, positions, norm_mix, w_in, g_q_lat, g_kv_lat, w_uq, w_ukv, g_q_head, g_k_head,
              w_conv, g_out_attn, g_out_conv, w_out, norm_moe, w_group, b_group, w_router, b_router,
              w1, w3, w2, norm_ple, w_ple, w_ple_gate, b_ple_gate):
    h = x
    splits = np.cumsum([Q_RANK, KV_RANK, QK_ROPE, D_CONV, D_CONV]).tolist()
    for i in range(DEPTH):
        xn = rms_norm(h, norm_mix[i])
        proj = xn @ w_in[i]
        q_lat, kv_lat, k_rope, b_gate, c_gate, h_conv = jnp.split(proj, splits, axis=-1)
        y_attn = mla_mixer(q_lat, kv_lat, k_rope, positions, g_q_lat[i], g_kv_lat[i],
                           w_uq[i], w_ukv[i], g_q_head[i], g_k_head[i])
        y_conv = short_conv_mixer(b_gate, c_gate, h_conv, w_conv[i])
        y_mix = jnp.concatenate([rms_norm(y_attn, g_out_attn[i]), rms_norm(y_conv, g_out_conv[i])], axis=-1)
        h = h + y_mix @ w_out[i]
        h = h + hier_moe(rms_norm(h, norm_moe[i]), w_group[i], b_group[i], w_router[i], b_router[i],
                         w1[i], w3[i], w2[i])
        gate = jax.nn.sigmoid(rms_norm(h, norm_ple[i]) @ w_ple_gate[i] + b_ple_gate[i])
        h = h + gate * (p[i] @ w_ple[i])
    return h
```

```cpp
#include <hip/hip_runtime.h>
#include <cstdio>
#include <cstdint>
#include <cmath>

#ifndef USE_PG8
#define USE_PG8 1
#endif

#define GAS __attribute__((address_space(1)))
#define LAS __attribute__((address_space(3)))
typedef unsigned short bf16;
typedef short bf16x8 __attribute__((ext_vector_type(8)));
typedef short s16x4 __attribute__((ext_vector_type(4)));
typedef float f32x4 __attribute__((ext_vector_type(4)));
typedef float f32x16 __attribute__((ext_vector_type(16)));
typedef unsigned u32x4 __attribute__((ext_vector_type(4)));
typedef unsigned u32x2 __attribute__((ext_vector_type(2)));
typedef GAS unsigned gu32;

constexpr int T_TOK = 8192, SEQ = 4096, DM = 2048, DIN = 3904, DINP = 4096;
constexpr int QR = 512, KVR = 256, ROPE = 64, DC = 1024, NH = 8, QKH = 192, VH = 128;
constexpr int NE = 32, DE = 512, PLE = 256;
constexpr int OFF_QLAT = 0, OFF_KVLAT = 512, OFF_KROPE = 768, OFF_B = 832, OFF_C = 1856, OFF_H = 2880;
constexpr float EPS = 1e-6f;
constexpr int MAXROWS = 24576;

constexpr size_t MiB = 1u << 20;
constexpr size_t WS_CTL = 0, CTL_ZERO_BYTES = 1 * MiB;
constexpr size_t WS_CS = 1 * MiB;
constexpr size_t WS_WTOP = 3 * MiB;
constexpr size_t WS_ROWTOK = 3 * MiB + 256 * 1024;
constexpr size_t WS_RS = 3 * MiB + 512 * 1024;
constexpr size_t WS_LIST = 4 * MiB;
constexpr size_t WS_WIN = 5 * MiB;
constexpr size_t WS_WUQ = 21 * MiB;
constexpr size_t WS_WUKV = 23 * MiB;
constexpr size_t WS_WPLE = 24 * MiB;
constexpr size_t WS_WOUT = 25 * MiB;
constexpr size_t WS_WPG = 33 * MiB;
constexpr size_t WS_W13 = 41 * MiB;
constexpr size_t WS_W2 = 169 * MiB;
constexpr size_t WS_R1 = 233 * MiB;
constexpr size_t WS_R2 = 265 * MiB;
constexpr size_t WS_PE = 329 * MiB;
constexpr size_t WS_R4 = 361 * MiB;
constexpr size_t WS_KVRAW = 393 * MiB;
constexpr size_t WS_Q = 425 * MiB;
constexpr size_t WS_K = 449 * MiB;
constexpr size_t WS_QLN = 473 * MiB;
constexpr size_t WS_KVLN = 481 * MiB;
constexpr size_t WS_PB = 485 * MiB;
constexpr size_t WS_XS = 393 * MiB;
constexpr size_t WS_END = 489 * MiB;
constexpr int CW_TMO = 0, CW_CODE = 1, CW_BAR = 4096, CW_CNT = 16384, CW_QCONV = 16512;

constexpr int RING_OFF = 0, RING_BYTES = 131072;
constexpr int LDSCTL_OFF = RING_BYTES, MISC_OFF = LDSCTL_OFF + 320;
constexpr int LDS_BYTES = 147456;
constexpr int NWAVES = 8;

#define LDS_WAIT() asm volatile("s_waitcnt lgkmcnt(0)" ::: "memory")
#define VM_WAIT() asm volatile("s_waitcnt vmcnt(0)" ::: "memory")
#define RLX_AGENT __ATOMIC_RELAXED, __HIP_MEMORY_SCOPE_AGENT

__device__ __forceinline__ unsigned f2bf(float f) { unsigned u = __builtin_bit_cast(unsigned, f); return (u + 0x7fffu + ((u >> 16) & 1u)) >> 16; }
__device__ __forceinline__ unsigned pk2(float lo, float hi) { return f2bf(lo) | (f2bf(hi) << 16); }
__device__ __forceinline__ float bf2f(unsigned short b) { return __builtin_bit_cast(float, (unsigned)b << 16); }
__device__ __forceinline__ float bflo(unsigned w) { return __builtin_bit_cast(float, w << 16); }
__device__ __forceinline__ float bfhi(unsigned w) { return __builtin_bit_cast(float, w & 0xffff0000u); }
__device__ __forceinline__ float wave_sum(float v) {
#pragma unroll
    for (int o = 1; o < 64; o <<= 1) v += __shfl_xor(v, o);
    return v;
}

namespace pg8 {
#define PG8_LAS __attribute__((address_space(3)))
typedef unsigned short bf16_t;
constexpr int BM = 256, BK = 64, HALF = 128, HTB = HALF * BK * 2, STAGE_BYTES = 8 * HTB, NXCD = 8, WGM = 8;
__host__ __device__ __forceinline__ int lds_byte(int r, int c) { const int st = (r >> 4) * 2 + (c >> 5), rr = r & 15, cc = c & 31, ob = rr * 64 + cc * 2; return st * 1024 + (ob ^ (((ob >> 9) & 1) << 5)); }
__host__ __device__ __forceinline__ void stage_rc(int b, int& R, int& C) { const int st = b / 1024, sb = b % 1024, swz = sb ^ (((sb >> 9) & 1) << 5); R = (st >> 1) * 16 + swz / 64; C = (st & 1) * 32 + (swz % 64) / 2; }
__host__ __device__ __forceinline__ int perm32(int rho) { const int n = rho >> 4, i = rho & 15; return 8 * (i >> 2) + 4 * n + (i & 3); }

struct Unit { int pm, pn, pb; };
struct Gemm { const bf16_t* A; const bf16_t* Bt; int M, N, K; };

struct StaticOrder {
    int nM, nN, nwg, G, c;
    __host__ __device__ void init(int M, int N, int G_, int c_) { nM = M / BM; nN = N / BM; nwg = nM * nN; G = G_; c = c_; }
    __host__ __device__ bool next(int i, Unit& u) const {
        const long L = (long)i * G + c; if (L >= nwg) return false;
        int wgid = (int)L; { const int q = nwg / NXCD, r = nwg % NXCD, xcd = wgid % NXCD, off = wgid / NXCD; wgid = (xcd < r ? xcd * (q + 1) : r * (q + 1) + (xcd - r) * q) + off; }
        const int nig = WGM * nN, gid = wgid / nig, fm = gid * WGM, gsz = (nM - fm) < WGM ? (nM - fm) : WGM;
        u.pm = fm + ((wgid % nig) % gsz); u.pn = (wgid % nig) / gsz; u.pb = u.pn; return true;
    }
    __device__ __forceinline__ void a_ready(const Unit&) const {}
    __device__ __forceinline__ void done(const Unit&) const {}
};
struct MoeOrder {
    const volatile LAS int* toff; int NPN, G, c;
    __device__ __forceinline__ bool next(int i, Unit& u) const {
        const int L = i * G + c; const int nt = toff[NE];
        if (L >= nt * NPN) return false;
        const int tile = L / NPN, pn = L - tile * NPN; int e = 0;
#pragma unroll 1
        for (int j = 1; j < NE; ++j) if (toff[j] <= tile) e = j;
        u.pm = tile; u.pn = pn; u.pb = e * NPN + pn; return true;
    }
    __device__ __forceinline__ void a_ready(const Unit&) const {}
    __device__ __forceinline__ void done(const Unit&) const {}
};

template <class Epi, class Sched>
__device__ __forceinline__ void gemm_simple(const Gemm g, const Sched& S, const Epi& E) {
    const int tid = threadIdx.x, wid = __builtin_amdgcn_readfirstlane(tid >> 6), lane = tid & 63, wr = wid >> 2, wc = wid & 3, fr = lane & 15, fq = lane >> 4;
    const int K = g.K;
    Unit u;
    for (int i = 0; S.next(i, u); ++i) {
        f32x4 acc[2][2][4][2];
#pragma unroll
        for (int a = 0; a < 2; ++a)
#pragma unroll
            for (int b = 0; b < 2; ++b)
#pragma unroll
                for (int m = 0; m < 4; ++m)
#pragma unroll
                    for (int n = 0; n < 2; ++n) acc[a][b][m][n] = (f32x4){0.f, 0.f, 0.f, 0.f};
        const bf16_t* Ab = g.A + (size_t)(u.pm * BM + wr * 64 + fr) * K + fq * 8;
        const bf16_t* Bb = g.Bt + (size_t)(u.pb * BM + wc * 32 + fr) * K + fq * 8;
#pragma unroll 1
        for (int k0 = 0; k0 < K; k0 += 32) {
            bf16x8 a[2][4], b[2][2];
#pragma unroll
            for (int ai = 0; ai < 2; ++ai)
#pragma unroll
                for (int m = 0; m < 4; ++m) a[ai][m] = *(const bf16x8*)(Ab + (size_t)(ai * HALF + m * 16) * K + k0);
#pragma unroll
            for (int bj = 0; bj < 2; ++bj)
#pragma unroll
                for (int n = 0; n < 2; ++n) b[bj][n] = *(const bf16x8*)(Bb + (size_t)(bj * HALF + n * 16) * K + k0);
#pragma unroll
            for (int ai = 0; ai < 2; ++ai)
#pragma unroll
                for (int bj = 0; bj < 2; ++bj)
#pragma unroll
                    for (int m = 0; m < 4; ++m)
#pragma unroll
                        for (int n = 0; n < 2; ++n) acc[ai][bj][m][n] = __builtin_amdgcn_mfma_f32_16x16x32_bf16(b[bj][n], a[ai][m], acc[ai][bj][m][n], 0, 0, 0);
        }
        E(acc, u, wr, wc, fr, fq);
    }
}
template <class Epi, class Sched, bool ALIGN_EPI = false, bool SP2 = false>
__device__ __forceinline__ void gemm_phase(PG8_LAS unsigned char* lds, const Gemm g, const Sched& S, const Epi& E) {
    int tid_ = threadIdx.x; asm volatile("" : "+v"(tid_));
    const int tid = tid_, wid = __builtin_amdgcn_readfirstlane(tid >> 6), lane = tid & 63, wr = wid >> 2, wc = wid & 3, fr = lane & 15, fq = lane >> 4;
    const int K = g.K, nt = K / BK;
    unsigned voffA[2], voffB[2];
#pragma unroll
    for (int i = 0; i < 2; ++i) { int R, C; stage_rc(tid * 16 + i * 8192, R, C); const int Rb = Epi::PERM ? ((R & ~31) + perm32(R & 31)) : R;
        voffA[i] = (unsigned)(R * K + C) * 2u; voffB[i] = (unsigned)(Rb * K + C) * 2u; }
    const size_t kstep = (size_t)(BK * 2);
    const size_t hstep = (size_t)HALF * K * 2;
    const size_t tstep = 2 * hstep;
    const unsigned ldsw = (unsigned)wid * 1024u;
    const int aoff = lds_byte(wr * 64 + fr, fq * 8), boff = lds_byte(wc * 32 + fr, fq * 8);
#define PG8_SA(b, h) (((b) * 2 + (h)) * HTB)
#define PG8_SB(b, h) ((4 + (b) * 2 + (h)) * HTB)
#define PG8_STAGE(bufoff, gbase, voff) do { _Pragma("unroll") for (int _i = 0; _i < 2; ++_i) \
        __builtin_amdgcn_global_load_lds((const unsigned*)((const char*)(gbase) + (voff)[_i]), (PG8_LAS unsigned*)(lds + (bufoff) + ldsw + _i * 8192), 16, 0, 0); } while (0)
#define PG8_LDA(dst, b, h) do { _Pragma("unroll") for (int m = 0; m < 4; ++m) _Pragma("unroll") for (int k = 0; k < 2; ++k) dst[m][k] = *(const PG8_LAS bf16x8*)(lds + PG8_SA(b, h) + aoff + m * 2048 + k * 1024); } while (0)
#define PG8_LDB(dst, b, h) do { _Pragma("unroll") for (int n = 0; n < 2; ++n) _Pragma("unroll") for (int k = 0; k < 2; ++k) dst[n][k] = *(const PG8_LAS bf16x8*)(lds + PG8_SB(b, h) + boff + n * 2048 + k * 1024); } while (0)
#define PG8_MMA(ai, bj, At, Bt) do { __builtin_amdgcn_s_setprio(1); _Pragma("unroll") for (int m = 0; m < 4; ++m) _Pragma("unroll") for (int n = 0; n < 2; ++n) _Pragma("unroll") for (int k = 0; k < 2; ++k) \
        acc[ai][bj][m][n] = __builtin_amdgcn_mfma_f32_16x16x32_bf16(Bt[n][k], At[m][k], acc[ai][bj][m][n], 0, 0, 0); __builtin_amdgcn_s_setprio(0); } while (0)
#define PG8_WAIT_V(n) asm volatile("s_waitcnt vmcnt(" #n ")" ::: "memory")
#define PG8_WAIT_L(n) asm volatile("s_waitcnt lgkmcnt(" #n ")" ::: "memory")
#define PG8_BAR __builtin_amdgcn_s_barrier()
#define PG8_SCHED __builtin_amdgcn_sched_barrier(0)
    Unit cur, nxt; int ui = 0;
    if (!S.next(0, cur)) return;
    f32x4 acc[2][2][4][2];
#pragma unroll
    for (int a = 0; a < 2; ++a)
#pragma unroll
        for (int b = 0; b < 2; ++b)
#pragma unroll
            for (int m = 0; m < 4; ++m)
#pragma unroll
                for (int n = 0; n < 2; ++n) acc[a][b][m][n] = (f32x4){0.f, 0.f, 0.f, 0.f};
    bf16x8 At[4][2], B0[2][2], B1[2][2];
    const char* cA = (const char*)g.A + (size_t)cur.pm * tstep; const char* cB = (const char*)g.Bt + (size_t)cur.pb * tstep;
    S.a_ready(cur);
    if constexpr (SP2) {
        PG8_STAGE(PG8_SB(0, 0), cB, voffB); PG8_STAGE(PG8_SB(0, 1), cB + hstep, voffB); PG8_STAGE(PG8_SA(0, 0), cA, voffA); PG8_STAGE(PG8_SA(0, 1), cA + hstep, voffA);
        if (wr == 1) PG8_BAR;
        PG8_WAIT_V(2); PG8_BAR;
        PG8_STAGE(PG8_SB(1, 0), cB + kstep, voffB); PG8_STAGE(PG8_SA(1, 0), cA + kstep, voffA); PG8_STAGE(PG8_SB(1, 1), cB + hstep + kstep, voffB);
        PG8_WAIT_V(6); PG8_BAR;
    } else {
        PG8_STAGE(PG8_SB(0, 0), cB, voffB); PG8_STAGE(PG8_SA(0, 0), cA, voffA); PG8_STAGE(PG8_SB(0, 1), cB + hstep, voffB); PG8_STAGE(PG8_SA(0, 1), cA + hstep, voffA);
        if (wr == 1) PG8_BAR;
        PG8_WAIT_V(4); PG8_BAR;
        PG8_STAGE(PG8_SB(1, 0), cB + kstep, voffB); PG8_STAGE(PG8_SA(1, 0), cA + kstep, voffA); PG8_STAGE(PG8_SB(1, 1), cB + hstep + kstep, voffB);
        PG8_WAIT_V(6); PG8_BAR;
    }
    for (;;) {
        const bool has_next = S.next(ui + 1, nxt);
        const char* nA = has_next ? (const char*)g.A + (size_t)nxt.pm * tstep : cA; const char* nB = has_next ? (const char*)g.Bt + (size_t)nxt.pb * tstep : cB;
        for (int t = 0; t < nt; t += 2) {
            const bool last = (t == nt - 2);
            const char* a1 = cA + (size_t)(t + 1) * kstep;
            const char* a2 = last ? nA : cA + (size_t)(t + 2) * kstep; const char* b2 = last ? nB : cB + (size_t)(t + 2) * kstep;
            const char* a3 = a2 + kstep; const char* b3 = b2 + kstep;
            if (last && has_next) S.a_ready(nxt);
            if constexpr (SP2) {
            PG8_LDB(B0, 0, 0); PG8_LDB(B1, 0, 1); PG8_SCHED; PG8_LDA(At, 0, 0); PG8_STAGE(PG8_SA(1, 1), a1 + hstep, voffA);
            PG8_WAIT_V(8); PG8_WAIT_L(0); PG8_BAR; PG8_MMA(0, 0, At, B0); PG8_MMA(0, 1, At, B1); PG8_BAR; PG8_SCHED;
            PG8_LDA(At, 0, 1); PG8_STAGE(PG8_SB(0, 0), b2, voffB); PG8_STAGE(PG8_SB(0, 1), b2 + hstep, voffB); PG8_STAGE(PG8_SA(0, 0), a2, voffA);
            PG8_WAIT_V(8); PG8_WAIT_L(0); PG8_BAR; PG8_MMA(1, 0, At, B0); PG8_MMA(1, 1, At, B1); PG8_BAR; PG8_SCHED;
            PG8_LDB(B0, 1, 0); PG8_LDB(B1, 1, 1); PG8_SCHED; PG8_LDA(At, 1, 0); PG8_STAGE(PG8_SA(0, 1), a2 + hstep, voffA);
            PG8_WAIT_V(8); PG8_WAIT_L(0); PG8_BAR; PG8_MMA(0, 0, At, B0); PG8_MMA(0, 1, At, B1); PG8_BAR; PG8_SCHED;
            PG8_LDA(At, 1, 1); PG8_STAGE(PG8_SB(1, 0), b3, voffB); PG8_STAGE(PG8_SB(1, 1), b3 + hstep, voffB); PG8_STAGE(PG8_SA(1, 0), a3, voffA);
            PG8_WAIT_V(8); PG8_WAIT_L(0); PG8_BAR; PG8_MMA(1, 0, At, B0); PG8_MMA(1, 1, At, B1); PG8_BAR; PG8_SCHED;
            } else {
            PG8_LDB(B0, 0, 0); PG8_SCHED; PG8_LDA(At, 0, 0); PG8_STAGE(PG8_SA(1, 1), a1 + hstep, voffA);
            PG8_WAIT_L(8); PG8_BAR; PG8_WAIT_L(0); PG8_MMA(0, 0, At, B0); PG8_BAR; PG8_SCHED;
            PG8_LDB(B1, 0, 1); PG8_STAGE(PG8_SB(0, 0), b2, voffB);
            PG8_BAR; PG8_WAIT_L(0); PG8_MMA(0, 1, At, B1); PG8_BAR;
            PG8_LDA(At, 0, 1); PG8_STAGE(PG8_SA(0, 0), a2, voffA);
            PG8_BAR; PG8_WAIT_L(0); PG8_MMA(1, 0, At, B0); PG8_BAR; PG8_SCHED;
            PG8_STAGE(PG8_SB(0, 1), b2 + hstep, voffB);
            PG8_WAIT_V(6); PG8_BAR; PG8_MMA(1, 1, At, B1); PG8_BAR;
            PG8_LDB(B0, 1, 0); PG8_SCHED; PG8_LDA(At, 1, 0); PG8_STAGE(PG8_SA(0, 1), a2 + hstep, voffA);
            PG8_WAIT_L(8); PG8_BAR; PG8_WAIT_L(0); PG8_MMA(0, 0, At, B0); PG8_BAR; PG8_SCHED;
            PG8_LDB(B1, 1, 1); PG8_STAGE(PG8_SB(1, 0), b3, voffB);
            PG8_BAR; PG8_WAIT_L(0); PG8_MMA(0, 1, At, B1); PG8_BAR;
            PG8_LDA(At, 1, 1); PG8_STAGE(PG8_SA(1, 0), a3, voffA);
            PG8_BAR; PG8_WAIT_L(0); PG8_MMA(1, 0, At, B0); PG8_BAR; PG8_SCHED;
            PG8_STAGE(PG8_SB(1, 1), b3 + hstep, voffB);
            PG8_WAIT_V(6); PG8_BAR; PG8_MMA(1, 1, At, B1); PG8_BAR;
            }
        }
        if constexpr (ALIGN_EPI) { if (wr == 0) PG8_BAR; }
        if constexpr (!Epi::AFTER_DRAIN) { E(acc, cur, wr, wc, fr, fq); S.done(cur); }
        if (!has_next) break;
#pragma unroll
        for (int a = 0; a < 2; ++a)
#pragma unroll
            for (int b = 0; b < 2; ++b)
#pragma unroll
                for (int m = 0; m < 4; ++m)
#pragma unroll
                    for (int n = 0; n < 2; ++n) acc[a][b][m][n] = (f32x4){0.f, 0.f, 0.f, 0.f};
        cur = nxt; cA = nA; cB = nB; ++ui;
        if constexpr (ALIGN_EPI) { if (wr == 1) PG8_BAR; }
    }
    PG8_WAIT_V(0);
    if constexpr (!ALIGN_EPI) { if (wr == 0) PG8_BAR; }
    PG8_BAR;
    if constexpr (Epi::AFTER_DRAIN) { E.fused(acc, cur, wr, wc, fr, fq, lds, wid, lane); S.done(cur); }
#undef PG8_SA
#undef PG8_SB
#undef PG8_STAGE
#undef PG8_LDA
#undef PG8_LDB
#undef PG8_MMA
#undef PG8_WAIT_V
#undef PG8_WAIT_L
#undef PG8_BAR
#undef PG8_SCHED
}
}

typedef f32x4 AccT[2][2][4][2];
struct EpiBf16Plain {
    static constexpr bool PERM = false, AFTER_DRAIN = false;
    bf16* O; int ldc;
    __device__ __forceinline__ void operator()(const AccT& acc, const pg8::Unit& u, int wr, int wc, int fr, int fq) const {
        const int row0 = u.pm * 256 + wr * 64 + fr, col0 = u.pn * 256 + wc * 32 + 4 * fq;
#pragma unroll
        for (int ai = 0; ai < 2; ++ai)
#pragma unroll
            for (int m = 0; m < 4; ++m) { bf16* rowp = O + (size_t)(row0 + ai * 128 + m * 16) * ldc + col0;
#pragma unroll
                for (int bj = 0; bj < 2; ++bj)
#pragma unroll
                    for (int n = 0; n < 2; ++n) { const f32x4 v = acc[ai][bj][m][n]; u32x2 w; w.x = pk2(v[0], v[1]); w.y = pk2(v[2], v[3]); *(u32x2*)(rowp + bj * 128 + n * 16) = w; } }
    }
};
struct EpiResF32 {
    static constexpr bool PERM = false, AFTER_DRAIN = false;
    const float* base; float* out; int ldc;
    __device__ __forceinline__ void operator()(const AccT& acc, const pg8::Unit& u, int wr, int wc, int fr, int fq) const {
        const int row0 = u.pm * 256 + wr * 64 + fr, col0 = u.pn * 256 + wc * 32 + 4 * fq;
#pragma unroll
        for (int ai = 0; ai < 2; ++ai)
#pragma unroll
            for (int m = 0; m < 4; ++m) { const size_t off = (size_t)(row0 + ai * 128 + m * 16) * ldc + col0;
#pragma unroll
                for (int bj = 0; bj < 2; ++bj)
#pragma unroll
                    for (int n = 0; n < 2; ++n) { const f32x4 b = *(const f32x4*)(base + off + bj * 128 + n * 16); *(f32x4*)(out + off + bj * 128 + n * 16) = b + acc[ai][bj][m][n]; } }
    }
};
struct EpiSwiGLU {
    static constexpr bool PERM = false, AFTER_DRAIN = false;
    bf16* H;
    __device__ __forceinline__ void operator()(const AccT& acc, const pg8::Unit& u, int wr, int wc, int fr, int fq) const {
        const int row0 = u.pm * 256 + wr * 64 + fr;
#pragma unroll
        for (int ai = 0; ai < 2; ++ai)
#pragma unroll
            for (int m = 0; m < 4; ++m) { bf16* rowp = H + (size_t)(row0 + ai * 128 + m * 16) * DE;
#pragma unroll
                for (int bj = 0; bj < 2; ++bj) { const f32x4 a = acc[ai][bj][m][0], b = acc[ai][bj][m][1]; float h[4];
#pragma unroll
                    for (int r = 0; r < 4; ++r) h[r] = a[r] / (1.f + __expf(-a[r])) * b[r];
                    u32x2 w; w.x = pk2(h[0], h[1]); w.y = pk2(h[2], h[3]);
                    *(u32x2*)(rowp + 16 * (u.pn * 8 + 4 * bj + wc) + 4 * fq) = w; } }
    }
};
struct EpiMoeOut {
    static constexpr bool PERM = false, AFTER_DRAIN = false;
    bf16* Y; const int* rowtok; const float* wtop;
    __device__ __forceinline__ void operator()(const AccT& acc, const pg8::Unit& u, int wr, int wc, int fr, int fq) const {
        const int row0 = u.pm * 256 + wr * 64 + fr, col0 = u.pn * 256 + wc * 32 + 4 * fq;
#pragma unroll
        for (int ai = 0; ai < 2; ++ai)
#pragma unroll
            for (int m = 0; m < 4; ++m) { const int tk = rowtok[row0 + ai * 128 + m * 16];
                if (tk >= 0) { const float w = wtop[tk]; bf16* rowp = Y + (size_t)tk * DM + col0;
#pragma unroll
                    for (int bj = 0; bj < 2; ++bj)
#pragma unroll
                        for (int n = 0; n < 2; ++n) { const f32x4 v = acc[ai][bj][m][n] * w; u32x2 q; q.x = pk2(v[0], v[1]); q.y = pk2(v[2], v[3]); *(u32x2*)(rowp + bj * 128 + n * 16) = q; } } }
    }
};
struct EpiGate {
    static constexpr bool PERM = false, AFTER_DRAIN = false;
    float* out; const bf16* PE; const float* bias;
    __device__ __forceinline__ void operator()(const AccT& acc, const pg8::Unit& u, int wr, int wc, int fr, int fq) const {
        const int row0 = u.pm * 256 + wr * 64 + fr, col0 = u.pn * 256 + wc * 32 + 4 * fq;
        f32x4 bv[2][2];
#pragma unroll
        for (int bj = 0; bj < 2; ++bj)
#pragma unroll
            for (int n = 0; n < 2; ++n) bv[bj][n] = *(const f32x4*)(bias + col0 + bj * 128 + n * 16);
#pragma unroll
        for (int ai = 0; ai < 2; ++ai)
#pragma unroll
            for (int m = 0; m < 4; ++m) { const size_t off = (size_t)(row0 + ai * 128 + m * 16) * DM + col0;
#pragma unroll
                for (int bj = 0; bj < 2; ++bj)
#pragma unroll
                    for (int n = 0; n < 2; ++n) { const size_t o2 = off + bj * 128 + n * 16;
                        const f32x4 h2 = *(const f32x4*)(out + o2); const u32x2 pw = *(const u32x2*)(PE + o2); const f32x4 z = acc[ai][bj][m][n] + bv[bj][n];
                        f32x4 r; r[0] = h2[0] + bflo(pw.x) / (1.f + __expf(-z[0])); r[1] = h2[1] + bfhi(pw.x) / (1.f + __expf(-z[1]));
                        r[2] = h2[2] + bflo(pw.y) / (1.f + __expf(-z[2])); r[3] = h2[3] + bfhi(pw.y) / (1.f + __expf(-z[3]));
                        *(f32x4*)(out + o2) = r; } }
    }
};
#define XB_TMO      128
#define XB_XCNT(j)  (256  + 64 * (j))
#define XB_XSUB(j)  (1280 + 64 * (j))
#define XB_XGEN(j)  (2304 + 64 * (j))
#define XB_TOP      3328
#define XB_TOPGEN   3392
#define XCD_BAR_WORDS 3456
#define XB_SPIN_CAP (1u << 22)

__device__ __forceinline__ unsigned xb_ld(unsigned* p)              { return __hip_atomic_load(p, __ATOMIC_RELAXED, __HIP_MEMORY_SCOPE_AGENT); }
__device__ __forceinline__ unsigned xb_add(unsigned* p, unsigned v) { return __hip_atomic_fetch_add(p, v, __ATOMIC_RELAXED, __HIP_MEMORY_SCOPE_AGENT); }
__device__ __forceinline__ unsigned xb_xcc_id() { return (unsigned)__builtin_amdgcn_s_getreg((3 << 11) | 20) & 0xFu; }
#define XB_SPIN(cond, bar) do { unsigned _sp = 0; while (cond) { __builtin_amdgcn_s_sleep(1); \
    if ((++_sp & 255u) == 0u) { if (xb_ld(&(bar)[XB_TMO])) break; if (_sp > XB_SPIN_CAP) { atomicAdd(&(bar)[XB_TMO], 1u); break; } } } } while (0)

struct XcdBarrier {
    unsigned* bar; unsigned x;
    volatile LAS unsigned* st;
};

__device__ __forceinline__ XcdBarrier xcd_barrier_post(unsigned* bar, volatile LAS unsigned* st) {
    XcdBarrier b; b.bar = bar; b.x = xb_xcc_id(); b.st = st;
    if (threadIdx.x == 0) (void)xb_add(&bar[XB_XCNT(b.x)], 1u);
    return b;
}
__device__ __forceinline__ void xcd_barrier_complete(unsigned* bar, unsigned x, unsigned& nloc, unsigned& nx) {
    const unsigned G = gridDim.x * gridDim.y * gridDim.z;
    unsigned sum, cnt, mine, sp = 0u;
    for (;;) {
        sum = 0u; cnt = 0u; mine = 0u;
#pragma unroll
        for (unsigned j = 0; j < 16; ++j) { const unsigned c = xb_ld(&bar[XB_XCNT(j)]); sum += c; cnt += (c > 0u) ? 1u : 0u; mine = (j == x) ? c : mine; }
        if (sum == G) break;
        __builtin_amdgcn_s_sleep(1);
        if ((++sp & 255u) == 0u) { if (xb_ld(&bar[XB_TMO])) break; if (sp > XB_SPIN_CAP) { atomicAdd(&bar[XB_TMO], 1u); break; } }
    }
    nloc = mine > 0u ? mine : 1u; nx = cnt > 0u ? cnt : 1u;
}

__device__ __forceinline__ void xcd_barrier(const XcdBarrier& b) {
    asm volatile("s_waitcnt vmcnt(0)" ::: "memory");
    __syncthreads();
    if (threadIdx.x == 0) {
        unsigned* bar = b.bar;
        __builtin_amdgcn_s_waitcnt(0);
        unsigned nloc = b.st[0], nx = b.st[1];
        if (nloc == 0u) { xcd_barrier_complete(bar, b.x, nloc, nx); b.st[0] = nloc; b.st[1] = nx; }
        const unsigned old = xb_add(&bar[XB_XSUB(b.x)], 1u);
        const unsigned gen = old / nloc;
        if (old + 1u == (gen + 1u) * nloc) {
            __builtin_amdgcn_fence(__ATOMIC_RELEASE, "agent");
            asm volatile("s_waitcnt vmcnt(0)" ::: "memory");
            const unsigned og = xb_add(&bar[XB_TOP], 1u);
            const unsigned tg = og / nx;
            if (og + 1u == (tg + 1u) * nx) xb_add(&bar[XB_TOPGEN], 1u);
            else XB_SPIN(xb_ld(&bar[XB_TOPGEN]) == tg, bar);
            __builtin_amdgcn_fence(__ATOMIC_ACQUIRE, "agent");
            xb_add(&bar[XB_XGEN(b.x)], 1u);
            asm volatile("s_waitcnt vmcnt(0)" ::: "memory");
        } else {
            XB_SPIN(xb_ld(&bar[XB_XGEN(b.x)]) == gen, bar);
            __builtin_amdgcn_fence(__ATOMIC_ACQUIRE, "agent");
            asm volatile("s_waitcnt vmcnt(0)" ::: "memory");
        }
    }
    __syncthreads();
}

namespace att {
constexpr int DQ = 192, NW = 8, QBLK = 32, KVBLK = 64;
constexpr float SCALE = 0.07216878364870322f;
constexpr float THR = 8.f;
constexpr int LDQ = 192, LDKK = 192, LDV = 2048, LDO = 1024;
constexpr int SHM_V = KVBLK * 128 * 2, SHM_K = KVBLK * DQ * 2, SHM_ATTN = 2 * SHM_V + 2 * SHM_K + NW * 64 * 4;
#define KSWZ(row, colB) ((row) * 384 + ((colB) ^ (((row) & 7) << 4)))
#define SBAR() __builtin_amdgcn_sched_barrier(0)
__device__ __forceinline__ int crow(int r, int hi) { return (r & 3) + 8 * (r >> 2) + 4 * hi; }
__device__ __forceinline__ unsigned cvtpk(float lo, float hi) { unsigned r; asm volatile("v_cvt_pk_bf16_f32 %0, %1, %2" : "=v"(r) : "v"(lo), "v"(hi)); return r; }

__device__ __forceinline__ void partialSM(f32x16& p0, f32x16& p1, float& m_reg, float& mn, float& alpha) {
  constexpr float C = SCALE * 1.4426950408889634f;
  float pmax = p0[0];
#pragma unroll
  for (int r = 1; r < 16; ++r) pmax = fmaxf(pmax, p0[r]);
#pragma unroll
  for (int r = 0; r < 16; ++r) pmax = fmaxf(pmax, p1[r]);
  { auto rr = __builtin_amdgcn_permlane32_swap(__float_as_uint(pmax), __float_as_uint(pmax), false, false);
    pmax = fmaxf(__uint_as_float(rr[0]), __uint_as_float(rr[1])); }
  if (__builtin_expect(__all(pmax - m_reg <= THR / SCALE), 1)) { mn = m_reg; alpha = 1.f; }
  else { mn = fmaxf(m_reg, pmax); alpha = __builtin_amdgcn_exp2f((m_reg - mn) * C); m_reg = mn; }
  float mnC = -mn * C;
#pragma unroll
  for (int r = 0; r < 16; ++r) p0[r] = fmaf(p0[r], C, mnC);
#pragma unroll
  for (int r = 0; r < 16; ++r) p1[r] = fmaf(p1[r], C, mnC);
#pragma unroll
  for (int r = 0; r < 16; ++r) p0[r] = __builtin_amdgcn_exp2f(p0[r]);
}
__device__ __forceinline__ void finishSM(f32x16& p0, f32x16& p1, float alpha, float& l_reg, bf16x8& pa0, bf16x8& pa1, bf16x8& pa2, bf16x8& pa3) {
#pragma unroll
  for (int r = 0; r < 16; ++r) p1[r] = __builtin_amdgcn_exp2f(p1[r]);
  float ps = 0;
#pragma unroll
  for (int r = 0; r < 16; ++r) ps += p0[r];
#pragma unroll
  for (int r = 0; r < 16; ++r) ps += p1[r];
  { auto rr = __builtin_amdgcn_permlane32_swap(__float_as_uint(ps), __float_as_uint(ps), false, false);
    ps = __uint_as_float(rr[0]) + __uint_as_float(rr[1]); }
  l_reg = l_reg * alpha + ps;
#define PK4(P, BASE, OUT) do { unsigned a0 = cvtpk(P[BASE + 0], P[BASE + 1]), a1 = cvtpk(P[BASE + 2], P[BASE + 3]);   \
    unsigned b0 = cvtpk(P[BASE + 4], P[BASE + 5]), b1 = cvtpk(P[BASE + 6], P[BASE + 7]);                              \
    auto r0 = __builtin_amdgcn_permlane32_swap(a0, b0, false, false); auto r1 = __builtin_amdgcn_permlane32_swap(a1, b1, false, false); \
    u32x4 w = {r0[0], r1[0], r0[1], r1[1]}; OUT = *reinterpret_cast<bf16x8*>(&w); } while (0)
  PK4(p0, 0, pa0); PK4(p0, 8, pa1); PK4(p1, 0, pa2); PK4(p1, 8, pa3);
#undef PK4
}
__device__ __forceinline__ void qkt(f32x16& p0, f32x16& p1, const char* Ks, const bf16x8* qr, int r32, int hi, bool dead) {
  p0 = f32x16{}; p1 = f32x16{};
#pragma unroll
  for (int d0 = 0; d0 < 12; ++d0) { const int cb = (d0 * 16 + hi * 8) * 2;
    bf16x8 b0 = *reinterpret_cast<const bf16x8*>(Ks + KSWZ(r32, cb));
    bf16x8 b1 = *reinterpret_cast<const bf16x8*>(Ks + KSWZ(32 + r32, cb));
    p0 = __builtin_amdgcn_mfma_f32_32x32x16_bf16(b0, qr[d0], p0, 0, 0, 0);
    p1 = __builtin_amdgcn_mfma_f32_32x32x16_bf16(b1, qr[d0], p1, 0, 0, 0);
    if ((d0 & 3) == 3) SBAR(); }
  if (dead) {
#pragma unroll
    for (int r = 0; r < 16; ++r) { p0[r] = -1e30f; p1[r] = -1e30f; } }
}
__device__ __forceinline__ int v_st(int k, int c) { const int kk = (k & ~0xC) | ((k & 4) << 1) | ((k & 8) >> 1); return ((kk >> 3) * 4 + (c >> 5)) * 512 + ((kk & 7) * 32 + (c & 31)) * 2; }
__device__ __forceinline__ int v_rd_base(int lane) { return ((lane & 3) << 3) | (((lane >> 2) & 3) << 6) | (((lane >> 4) & 1) << 5) | (((lane >> 5) & 1) << 8); }
constexpr int v_rd_off(int d0, int ks, int half) { return d0 * 512 + ks * 4096 + half * 2048; }
template <int OFF> __device__ __forceinline__ s16x4 tr_read(int vb) {
  s16x4 r; asm volatile("ds_read_b64_tr_b16 %0, %1 offset:%2" : "=&v"(r) : "v"(vb), "i"(OFF) : "memory"); return r;
}
template <int D0> __device__ __forceinline__ void pv_one(f32x16& od, int vb, bf16x8 pa0, bf16x8 pa1, bf16x8 pa2, bf16x8 pa3) {
  const s16x4 l0 = tr_read<v_rd_off(D0, 0, 0)>(vb), h0 = tr_read<v_rd_off(D0, 0, 1)>(vb), l1 = tr_read<v_rd_off(D0, 1, 0)>(vb), h1 = tr_read<v_rd_off(D0, 1, 1)>(vb);
  const s16x4 l2 = tr_read<v_rd_off(D0, 2, 0)>(vb), h2 = tr_read<v_rd_off(D0, 2, 1)>(vb), l3 = tr_read<v_rd_off(D0, 3, 0)>(vb), h3 = tr_read<v_rd_off(D0, 3, 1)>(vb);
  asm volatile("s_waitcnt lgkmcnt(0)" ::: "memory"); SBAR();
#define PK(L, H) (bf16x8){L[0], L[1], L[2], L[3], H[0], H[1], H[2], H[3]}
  od = __builtin_amdgcn_mfma_f32_32x32x16_bf16(pa0, PK(l0, h0), od, 0, 0, 0);
  od = __builtin_amdgcn_mfma_f32_32x32x16_bf16(pa1, PK(l1, h1), od, 0, 0, 0);
  od = __builtin_amdgcn_mfma_f32_32x32x16_bf16(pa2, PK(l2, h2), od, 0, 0, 0);
  od = __builtin_amdgcn_mfma_f32_32x32x16_bf16(pa3, PK(l3, h3), od, 0, 0, 0);
#undef PK
}
__device__ __forceinline__ void pv_d0(f32x16* o, int vb, bf16x8 pa0, bf16x8 pa1, bf16x8 pa2, bf16x8 pa3) {
  pv_one<0>(o[0], vb, pa0, pa1, pa2, pa3); pv_one<1>(o[1], vb, pa0, pa1, pa2, pa3); pv_one<2>(o[2], vb, pa0, pa1, pa2, pa3); pv_one<3>(o[3], vb, pa0, pa1, pa2, pa3);
}

__device__ __forceinline__ void attn_unit(const bf16* __restrict__ Qb, const bf16* __restrict__ Kh, const bf16* __restrict__ Vh, bf16* __restrict__ Ob, int qb, char* lds) {
  int tid_ = threadIdx.x; asm volatile("" : "+v"(tid_));
  const int tid = tid_, wid = tid >> 6, lane = tid & 63, r32 = lane & 31, hi = lane >> 5;
  char* V_lds = lds; char* K_lds = lds + 2 * SHM_V;
  float* ws = (float*)(lds + 2 * SHM_V + 2 * SHM_K) + wid * 64; float* li_l = ws; float* al_l = ws + 32;
  float m_reg = -1e30f, l_reg = 0; f32x16 o[4] = {}; bf16x8 qr[12];
  const bf16* Qw = Qb + (long)(wid * QBLK + r32) * LDQ + hi * 8;
#pragma unroll
  for (int d0 = 0; d0 < 12; ++d0) qr[d0] = *reinterpret_cast<const bf16x8*>(Qw + d0 * 16);
  const int sr = tid >> 4, sc = (tid & 15) * 8, vst0 = v_st(sr, sc), vst1 = v_st(32 + sr, sc);
  const int kr = tid >> 3, kc = 128 + (tid & 7) * 8;
  const int vb0 = (int)(uintptr_t)V_lds + v_rd_base(lane);
  const int NT = 4 * qb + 4, NTw = 4 * qb + 1 + (wid >> 1);
  bf16x8 vs0, vs1, ks0, ks1, ks2;
#define SLOAD(k0) do { vs0 = *reinterpret_cast<const bf16x8*>(&Vh[(long)((k0) + sr) * LDV + sc]); vs1 = *reinterpret_cast<const bf16x8*>(&Vh[(long)((k0) + 32 + sr) * LDV + sc]); \
    ks0 = *reinterpret_cast<const bf16x8*>(&Kh[(long)((k0) + sr) * LDKK + sc]); ks1 = *reinterpret_cast<const bf16x8*>(&Kh[(long)((k0) + 32 + sr) * LDKK + sc]); \
    ks2 = *reinterpret_cast<const bf16x8*>(&Kh[(long)((k0) + kr) * LDKK + kc]); } while (0)
#define SWRITE(b) do { *(bf16x8*)(V_lds + (b) * SHM_V + vst0) = vs0; *(bf16x8*)(V_lds + (b) * SHM_V + vst1) = vs1; \
    *(bf16x8*)(K_lds + (b) * SHM_K + KSWZ(sr, sc * 2)) = ks0; *(bf16x8*)(K_lds + (b) * SHM_K + KSWZ(32 + sr, sc * 2)) = ks1; \
    *(bf16x8*)(K_lds + (b) * SHM_K + KSWZ(kr, kc * 2)) = ks2; } while (0)
#define SWAIT() asm volatile("s_waitcnt vmcnt(0)" ::: "memory")
#define RESC(a) do { if (__any((a) < 1.f)) { if (hi == 0) al_l[r32] = (a); asm volatile("s_waitcnt lgkmcnt(0)" ::: "memory"); \
    _Pragma("unroll") for (int d = 0; d < 4; ++d) _Pragma("unroll") for (int r = 0; r < 16; ++r) o[d][r] *= al_l[crow(r, hi)]; } } while (0)
  f32x16 pA0, pA1; float mnA, alA; bf16x8 pa0, pa1, pa2, pa3;
  SLOAD(0); SWAIT(); SWRITE(0); __syncthreads();
#pragma unroll 1
  for (int j = 0; j < NT; ++j) {
    const int cur = j & 1;
    if (j + 1 < NT) SLOAD((j + 1) * KVBLK);
    SBAR(); qkt(pA0, pA1, K_lds + cur * SHM_K, qr, r32, hi, j >= NTw);
    partialSM(pA0, pA1, m_reg, mnA, alA);
    RESC(alA);
    finishSM(pA0, pA1, alA, l_reg, pa0, pa1, pa2, pa3); SBAR();
    pv_d0(o, vb0 + cur * SHM_V, pa0, pa1, pa2, pa3);
    if (j + 1 < NT) { SWAIT(); SWRITE(cur ^ 1); }
    __syncthreads();
  }
  if (hi == 0) li_l[r32] = l_reg; asm volatile("s_waitcnt lgkmcnt(0)" ::: "memory");
  float rli[16];
#pragma unroll
  for (int r = 0; r < 16; ++r) rli[r] = __builtin_amdgcn_rcpf(li_l[crow(r, hi)]);
  bf16* Ow = Ob + (long)(wid * QBLK) * LDO;
#pragma unroll
  for (int r = 0; r < 16; ++r) { const int orow = crow(r, hi);
#pragma unroll
    for (int d0 = 0; d0 < 4; ++d0) Ow[(long)orow * LDO + d0 * 32 + r32] = (bf16)f2bf(o[d0][r] * rli[r]); }
  __syncthreads();
#undef SLOAD
#undef SWRITE
#undef SWAIT
#undef RESC
}
#undef SBAR
}

struct Args {
    const float* in[27]; float* out; unsigned char* ws; float freq[32];
};
struct Frame {
    LAS unsigned char* lds;
    volatile LAS unsigned* MISC;
    gu32* ctl;
    int tid, lane, wave, vcu, G;
};
enum { I_X = 0, I_P, I_POS, I_NORM_MIX, I_W_IN, I_G_QLAT, I_G_KVLAT, I_W_UQ, I_W_UKV, I_G_QHEAD, I_G_KHEAD, I_W_CONV, I_G_OUT_ATTN, I_G_OUT_CONV, I_W_OUT,
       I_NORM_MOE, I_W_GROUP, I_B_GROUP, I_W_ROUTER, I_B_ROUTER, I_W1, I_W3, I_W2, I_NORM_PLE, I_W_PLE, I_W_PLE_GATE, I_B_PLE_GATE };

template <int MODE> __device__ __forceinline__ int rowmap(int n) {
    if (MODE == 0) return n;
    if (MODE == 1) return (n / 192) * 256 + (n % 192);
    if (MODE == 2) return ((n >> 4) << 5) + (n & 15);
    return ((n >> 4) << 5) + 16 + (n & 15);
}
template <int MODE> __device__ __forceinline__ void transpose_item(const float* W, int K, int N, bf16* WT, LAS float* scr, int item, int lane) {
    const int nblk = N / 32, kb = item / nblk, nb = item % nblk, k0 = 64 * kb, n0 = 32 * nb;
#pragma unroll 8
    for (int i = 0; i < 32; ++i) { const int kk = 2 * i + (lane >> 5); scr[kk * 33 + (lane & 31)] = W[(size_t)(k0 + kk) * N + n0 + (lane & 31)]; }
    LDS_WAIT(); asm volatile("" ::: "memory");
    const int c = lane & 7;
#pragma unroll
    for (int j = 0; j < 4; ++j) { const int n = (lane >> 3) + 8 * j; const LAS float* s = scr + (8 * c) * 33 + n;
        u32x4 o; o.x = pk2(s[0 * 33], s[1 * 33]); o.y = pk2(s[2 * 33], s[3 * 33]); o.z = pk2(s[4 * 33], s[5 * 33]); o.w = pk2(s[6 * 33], s[7 * 33]);
        *(GAS u32x4*)(WT + (size_t)rowmap<MODE>(n0 + n) * K + k0 + 8 * c) = o; }
    LDS_WAIT(); asm volatile("" ::: "memory");
}
__device__ __forceinline__ void rms_row_to_bf16(const float* xrow, const float* g, bf16* orow, int lane) {
    const f32x4* xr = (const f32x4*)xrow + lane; const f32x4* gr = (const f32x4*)g + lane;
    f32x4 v[8]; float s = 0.f;
#pragma unroll
    for (int j = 0; j < 8; ++j) { v[j] = xr[64 * j]; s += (v[j].x * v[j].x + v[j].y * v[j].y) + (v[j].z * v[j].z + v[j].w * v[j].w); }
    const float rs = 1.0f / sqrtf(wave_sum(s) * (1.f / DM) + EPS);
    u32x2* o8 = (u32x2*)orow + lane;
#pragma unroll
    for (int j = 0; j < 8; ++j) { const f32x4 gg = gr[64 * j]; u32x2 w; w.x = pk2(v[j].x * rs * gg.x, v[j].y * rs * gg.y); w.y = pk2(v[j].z * rs * gg.z, v[j].w * rs * gg.w); o8[64 * j] = w; }
}

__device__ __forceinline__ void p0_prologue(Frame& F, const Args& a) {
    unsigned char* ws = a.ws;
    LAS float* scr = (LAS float*)(F.lds + RING_OFF + F.wave * 16384);
    const int gw = F.vcu * NWAVES + F.wave, NGW = F.G * NWAVES, lane = F.lane;
    bf16* WinT = (bf16*)(ws + WS_WIN); bf16* WuqT = (bf16*)(ws + WS_WUQ); bf16* WukvT = (bf16*)(ws + WS_WUKV); bf16* WpleT = (bf16*)(ws + WS_WPLE);
    bf16* WoutT = (bf16*)(ws + WS_WOUT); bf16* WpgT = (bf16*)(ws + WS_WPG); bf16* W13T = (bf16*)(ws + WS_W13); bf16* W2T = (bf16*)(ws + WS_W2);
    constexpr int I_IN = (DM / 64) * (DIN / 32), I_UQ = (QR / 64) * (NH * QKH / 32), I_UKV = (KVR / 64) * (DM / 32), I_OUT = (DM / 64) * (DM / 32), I_PG = I_OUT, I_PL = (PLE / 64) * (DM / 32);
    constexpr int I_E1 = (DM / 64) * (DE / 32), I_E2 = (DE / 64) * (DM / 32);
    constexpr int I_SMALL = I_IN + I_UQ + I_UKV + I_OUT + I_PG + I_PL;
    constexpr int NITEMS = I_SMALL;
    for (int it = gw; it < NITEMS; it += NGW) {
        int r = it;
        if (r < I_IN) { transpose_item<0>(a.in[I_W_IN], DM, DIN, WinT, scr, r, lane); continue; } r -= I_IN;
        if (r < I_UQ) { transpose_item<1>(a.in[I_W_UQ], QR, NH * QKH, WuqT, scr, r, lane); continue; } r -= I_UQ;
        if (r < I_UKV) { transpose_item<0>(a.in[I_W_UKV], KVR, DM, WukvT, scr, r, lane); continue; } r -= I_UKV;
        if (r < I_OUT) { transpose_item<0>(a.in[I_W_OUT], DM, DM, WoutT, scr, r, lane); continue; } r -= I_OUT;
        if (r < I_PG) { transpose_item<0>(a.in[I_W_PLE_GATE], DM, DM, WpgT, scr, r, lane); continue; } r -= I_PG;
        if (r < I_PL) { transpose_item<0>(a.in[I_W_PLE], PLE, DM, WpleT, scr, r, lane); continue; } r -= I_PL;
    }
    {
        const int gt = (F.vcu * NWAVES + F.wave) * 64 + lane, NGT = NGW * 64;
        const u32x4 z = {0u, 0u, 0u, 0u};
        for (int i = gt; i < (DINP - DIN) * DM / 8; i += NGT) *(u32x4*)(WinT + (size_t)DIN * DM + (size_t)i * 8) = z;
        for (int i = gt; i < NH * 64 * QR / 8; i += NGT) { const int h = i / (64 * QR / 8), rr = i % (64 * QR / 8); *(u32x4*)(WuqT + ((size_t)h * 256 + 192) * QR + (size_t)rr * 8) = z; }
        const float* p = a.in[I_P]; bf16* Pb = (bf16*)(ws + WS_PB);
        for (int i = gt; i < T_TOK * PLE / 8; i += NGT) { const f32x4 x0 = *(const f32x4*)(p + (size_t)i * 8), x1 = *(const f32x4*)(p + (size_t)i * 8 + 4);
            u32x4 w; w.x = pk2(x0.x, x0.y); w.y = pk2(x0.z, x0.w); w.z = pk2(x1.x, x1.y); w.w = pk2(x1.z, x1.w); *(u32x4*)(Pb + (size_t)i * 8) = w; }
        const int* pos = (const int*)a.in[I_POS]; float* CS = (float*)(ws + WS_CS);
        for (int i = gt; i < T_TOK * 32; i += NGT) { const int t = i >> 5, fi = i & 31;
            const float ang = (float)pos[t] * a.freq[fi];
            const double rev = (double)ang * 0.15915494309189535; const float fr = (float)(rev - rint(rev));
            CS[t * 64 + fi] = __builtin_amdgcn_cosf(fr); CS[t * 64 + 32 + fi] = __builtin_amdgcn_sinf(fr); }
    }
    bf16* XN = (bf16*)(ws + WS_R1);
    for (int m = gw; m < T_TOK; m += NGW) rms_row_to_bf16(a.in[I_X] + (size_t)m * DM, a.in[I_NORM_MIX], XN + (size_t)m * DM, lane);
}

__device__ __forceinline__ void moe_convert_dyn(Frame& F, const Args& a) {
    unsigned char* ws = a.ws;
    LAS float* scr = (LAS float*)(F.lds + RING_OFF + F.wave * 16384);
    bf16* W13T = (bf16*)(ws + WS_W13); bf16* W2T = (bf16*)(ws + WS_W2);
    constexpr int I_E1 = (DM / 64) * (DE / 32), I_E2 = (DE / 64) * (DM / 32), PER_E = 2 * I_E1 + I_E2, NIT = NE * PER_E;
    unsigned* ctr = (unsigned*)(ws + WS_CTL) + CW_QCONV;
    volatile LAS unsigned* slot = F.MISC + 12;
    const int lane = F.lane;
    for (;;) {
        if (F.tid == 0) slot[0] = atomicAdd(ctr, 64u);
        __syncthreads();
        const int base = (int)slot[0];
        __syncthreads();
        if (base >= NIT) break;
#pragma unroll 1
        for (int q = 0; q < 8; ++q) {
            const int it = base + F.wave * 8 + q; if (it >= NIT) break;
            const int e = it / PER_E; int r = it - e * PER_E;
            if (r < I_E1) transpose_item<2>(a.in[I_W1] + (size_t)e * DM * DE, DM, DE, W13T + (size_t)e * 1024 * DM, scr, r, lane);
            else if (r < 2 * I_E1) transpose_item<3>(a.in[I_W3] + (size_t)e * DM * DE, DM, DE, W13T + (size_t)e * 1024 * DM, scr, r - I_E1, lane);
            else transpose_item<0>(a.in[I_W2] + (size_t)e * DE * DM, DE, DM, W2T + (size_t)e * DM * DE, scr, r - 2 * I_E1, lane);
        }
    }
}

__device__ __forceinline__ void p2a_rows(Frame& F, const Args& a) {
    unsigned char* ws = a.ws;
    const bf16* PROJ = (const bf16*)(ws + WS_R2); bf16* QLN = (bf16*)(ws + WS_QLN); bf16* KVLN = (bf16*)(ws + WS_KVLN); bf16* YMIX = (bf16*)(ws + WS_R4);
    const float* gq = a.in[I_G_QLAT]; const float* gkv = a.in[I_G_KVLAT]; const float* wconv = a.in[I_W_CONV]; const float* gc = a.in[I_G_OUT_CONV];
    const int gw = F.vcu * NWAVES + F.wave, NGW = F.G * NWAVES, lane = F.lane;
    for (int t = gw; t < T_TOK; t += NGW) {
        const bf16* pr = PROJ + (size_t)t * DINP; const int s = t & (SEQ - 1);
        {
            const u32x4 w = *(const u32x4*)(pr + OFF_QLAT + lane * 8);
            float v[8] = {bflo(w.x), bfhi(w.x), bflo(w.y), bfhi(w.y), bflo(w.z), bfhi(w.z), bflo(w.w), bfhi(w.w)}; float ss = 0.f;
#pragma unroll
            for (int i = 0; i < 8; ++i) ss += v[i] * v[i];
            const float rs = 1.0f / sqrtf(wave_sum(ss) * (1.f / QR) + EPS);
            const f32x4 g0 = *(const f32x4*)(gq + lane * 8), g1 = *(const f32x4*)(gq + lane * 8 + 4);
            u32x4 o; o.x = pk2(v[0] * rs * g0.x, v[1] * rs * g0.y); o.y = pk2(v[2] * rs * g0.z, v[3] * rs * g0.w); o.z = pk2(v[4] * rs * g1.x, v[5] * rs * g1.y); o.w = pk2(v[6] * rs * g1.z, v[7] * rs * g1.w);
            *(u32x4*)(QLN + (size_t)t * QR + lane * 8) = o;
        }
        {
            const u32x2 w = *(const u32x2*)(pr + OFF_KVLAT + lane * 4);
            float v[4] = {bflo(w.x), bfhi(w.x), bflo(w.y), bfhi(w.y)}; float ss = (v[0] * v[0] + v[1] * v[1]) + (v[2] * v[2] + v[3] * v[3]);
            const float rs = 1.0f / sqrtf(wave_sum(ss) * (1.f / KVR) + EPS);
            const f32x4 g0 = *(const f32x4*)(gkv + lane * 4);
            u32x2 o; o.x = pk2(v[0] * rs * g0.x, v[1] * rs * g0.y); o.y = pk2(v[2] * rs * g0.z, v[3] * rs * g0.w);
            *(u32x2*)(KVLN + (size_t)t * KVR + lane * 4) = o;
        }
        {
            float y[16]; float ss = 0.f;
#pragma unroll
            for (int j = 0; j < 2; ++j) { const int ch = lane * 8 + 512 * j;
                float u0[8], u1[8], u2[8], bb[8];
                { const u32x4 c = *(const u32x4*)(pr + OFF_C + ch), h = *(const u32x4*)(pr + OFF_H + ch), b = *(const u32x4*)(pr + OFF_B + ch);
                  u2[0] = bflo(c.x) * bflo(h.x); u2[1] = bfhi(c.x) * bfhi(h.x); u2[2] = bflo(c.y) * bflo(h.y); u2[3] = bfhi(c.y) * bfhi(h.y);
                  u2[4] = bflo(c.z) * bflo(h.z); u2[5] = bfhi(c.z) * bfhi(h.z); u2[6] = bflo(c.w) * bflo(h.w); u2[7] = bfhi(c.w) * bfhi(h.w);
                  bb[0] = bflo(b.x); bb[1] = bfhi(b.x); bb[2] = bflo(b.y); bb[3] = bfhi(b.y); bb[4] = bflo(b.z); bb[5] = bfhi(b.z); bb[6] = bflo(b.w); bb[7] = bfhi(b.w); }
                if (s >= 1) { const bf16* p1 = pr - DINP; const u32x4 c = *(const u32x4*)(p1 + OFF_C + ch), h = *(const u32x4*)(p1 + OFF_H + ch);
                  u1[0] = bflo(c.x) * bflo(h.x); u1[1] = bfhi(c.x) * bfhi(h.x); u1[2] = bflo(c.y) * bflo(h.y); u1[3] = bfhi(c.y) * bfhi(h.y);
                  u1[4] = bflo(c.z) * bflo(h.z); u1[5] = bfhi(c.z) * bfhi(h.z); u1[6] = bflo(c.w) * bflo(h.w); u1[7] = bfhi(c.w) * bfhi(h.w); }
                else {
#pragma unroll
                  for (int i = 0; i < 8; ++i) u1[i] = 0.f; }
                if (s >= 2) { const bf16* p2 = pr - 2 * DINP; const u32x4 c = *(const u32x4*)(p2 + OFF_C + ch), h = *(const u32x4*)(p2 + OFF_H + ch);
                  u0[0] = bflo(c.x) * bflo(h.x); u0[1] = bfhi(c.x) * bfhi(h.x); u0[2] = bflo(c.y) * bflo(h.y); u0[3] = bfhi(c.y) * bfhi(h.y);
                  u0[4] = bflo(c.z) * bflo(h.z); u0[5] = bfhi(c.z) * bfhi(h.z); u0[6] = bflo(c.w) * bflo(h.w); u0[7] = bfhi(c.w) * bfhi(h.w); }
                else {
#pragma unroll
                  for (int i = 0; i < 8; ++i) u0[i] = 0.f; }
                float w0[8], w1[8], w2[8];
                { const f32x4 a0 = *(const f32x4*)(wconv + ch), a1 = *(const f32x4*)(wconv + ch + 4); w0[0] = a0.x; w0[1] = a0.y; w0[2] = a0.z; w0[3] = a0.w; w0[4] = a1.x; w0[5] = a1.y; w0[6] = a1.z; w0[7] = a1.w; }
                { const f32x4 a0 = *(const f32x4*)(wconv + DC + ch), a1 = *(const f32x4*)(wconv + DC + ch + 4); w1[0] = a0.x; w1[1] = a0.y; w1[2] = a0.z; w1[3] = a0.w; w1[4] = a1.x; w1[5] = a1.y; w1[6] = a1.z; w1[7] = a1.w; }
                { const f32x4 a0 = *(const f32x4*)(wconv + 2 * DC + ch), a1 = *(const f32x4*)(wconv + 2 * DC + ch + 4); w2[0] = a0.x; w2[1] = a0.y; w2[2] = a0.z; w2[3] = a0.w; w2[4] = a1.x; w2[5] = a1.y; w2[6] = a1.z; w2[7] = a1.w; }
#pragma unroll
                for (int i = 0; i < 8; ++i) { const float v = bb[i] * (u0[i] * w0[i] + u1[i] * w1[i] + u2[i] * w2[i]); y[j * 8 + i] = v; ss += v * v; }
            }
            const float rs = 1.0f / sqrtf(wave_sum(ss) * (1.f / DC) + EPS);
#pragma unroll
            for (int j = 0; j < 2; ++j) { const int ch = lane * 8 + 512 * j; const f32x4 g0 = *(const f32x4*)(gc + ch), g1 = *(const f32x4*)(gc + ch + 4);
                u32x4 o; o.x = pk2(y[j * 8 + 0] * rs * g0.x, y[j * 8 + 1] * rs * g0.y); o.y = pk2(y[j * 8 + 2] * rs * g0.z, y[j * 8 + 3] * rs * g0.w);
                o.z = pk2(y[j * 8 + 4] * rs * g1.x, y[j * 8 + 5] * rs * g1.y); o.w = pk2(y[j * 8 + 6] * rs * g1.z, y[j * 8 + 7] * rs * g1.w);
                *(u32x4*)(YMIX + (size_t)t * DM + DC + ch) = o; }
        }
    }
}

__device__ __forceinline__ void p2c_qk(Frame& F, const Args& a) {
    unsigned char* ws = a.ws;
    const bf16* QRAW = (const bf16*)(ws + WS_R1); const bf16* KVRAW = (const bf16*)(ws + WS_KVRAW); const bf16* PROJ = (const bf16*)(ws + WS_R2); const float* CS = (const float*)(ws + WS_CS);
    bf16* Q = (bf16*)(ws + WS_Q); bf16* K = (bf16*)(ws + WS_K);
    const float* gqh = a.in[I_G_QHEAD]; const float* gkh = a.in[I_G_KHEAD];
    const int gw = F.vcu * NWAVES + F.wave, NGW = F.G * NWAVES, lane = F.lane;
    const float gq0 = gqh[lane], gq1 = gqh[64 + lane], gq2 = gqh[128 + lane], gk0 = gkh[lane], gk1 = gkh[64 + lane], gk2 = gkh[128 + lane];
    for (int t = gw; t < T_TOK; t += NGW) {
        const int b = t >> 12, s = t & (SEQ - 1), fi = lane & 31;
        const float cs = CS[t * 64 + fi], sn = CS[t * 64 + 32 + fi];
        const float krope = bf2f(PROJ[(size_t)t * DINP + OFF_KROPE + lane]); const float ssr = wave_sum(krope * krope);
#pragma unroll 1
        for (int h = 0; h < NH; ++h) {
            {
                const bf16* q = QRAW + (size_t)t * DM + h * 256;
                const float x0 = bf2f(q[lane]), x1 = bf2f(q[64 + lane]), x2 = bf2f(q[128 + lane]);
                const float rs = 1.0f / sqrtf(wave_sum(x0 * x0 + x1 * x1 + x2 * x2) * (1.f / QKH) + EPS);
                const float y0 = x0 * rs * gq0, y1 = x1 * rs * gq1, y2 = x2 * rs * gq2;
                const float yp = __shfl_xor(y2, 32);
                const float r = (lane < 32) ? (y2 * cs - yp * sn) : (y2 * cs + yp * sn);
                bf16* o = Q + ((size_t)(b * NH + h) * SEQ + s) * QKH;
                o[lane] = (bf16)f2bf(y0); o[64 + lane] = (bf16)f2bf(y1); o[128 + lane] = (bf16)f2bf(r);
            }
            {
                const bf16* k = KVRAW + (size_t)t * DM + h * 256;
                const float x0 = bf2f(k[lane]), x1 = bf2f(k[64 + lane]);
                const float rs = 1.0f / sqrtf((wave_sum(x0 * x0 + x1 * x1) + ssr) * (1.f / QKH) + EPS);
                const float y0 = x0 * rs * gk0, y1 = x1 * rs * gk1, y2 = krope * rs * gk2;
                const float yp = __shfl_xor(y2, 32);
                const float r = (lane < 32) ? (y2 * cs - yp * sn) : (y2 * cs + yp * sn);
                bf16* o = K + ((size_t)(b * NH + h) * SEQ + s) * QKH;
                o[lane] = (bf16)f2bf(y0); o[64 + lane] = (bf16)f2bf(y1); o[128 + lane] = (bf16)f2bf(r);
            }
        }
    }
}

__device__ __forceinline__ void p3b_rows(Frame& F, const Args& a) {
    unsigned char* ws = a.ws;
    const bf16* O = (const bf16*)(ws + WS_R2); bf16* YMIX = (bf16*)(ws + WS_R4); const float* ga = a.in[I_G_OUT_ATTN];
    const int gw = F.vcu * NWAVES + F.wave, NGW = F.G * NWAVES, lane = F.lane;
    for (int t = gw; t < T_TOK; t += NGW) {
        float v[16]; float ss = 0.f;
#pragma unroll
        for (int j = 0; j < 2; ++j) { const u32x4 w = *(const u32x4*)(O + (size_t)t * 1024 + lane * 8 + 512 * j);
            v[j * 8 + 0] = bflo(w.x); v[j * 8 + 1] = bfhi(w.x); v[j * 8 + 2] = bflo(w.y); v[j * 8 + 3] = bfhi(w.y); v[j * 8 + 4] = bflo(w.z); v[j * 8 + 5] = bfhi(w.z); v[j * 8 + 6] = bflo(w.w); v[j * 8 + 7] = bfhi(w.w); }
#pragma unroll
        for (int i = 0; i < 16; ++i) ss += v[i] * v[i];
        const float rs = 1.0f / sqrtf(wave_sum(ss) * (1.f / 1024) + EPS);
#pragma unroll
        for (int j = 0; j < 2; ++j) { const int ch = lane * 8 + 512 * j; const f32x4 g0 = *(const f32x4*)(ga + ch), g1 = *(const f32x4*)(ga + ch + 4);
            u32x4 o; o.x = pk2(v[j * 8 + 0] * rs * g0.x, v[j * 8 + 1] * rs * g0.y); o.y = pk2(v[j * 8 + 2] * rs * g0.z, v[j * 8 + 3] * rs * g0.w);
            o.z = pk2(v[j * 8 + 4] * rs * g1.x, v[j * 8 + 5] * rs * g1.y); o.w = pk2(v[j * 8 + 6] * rs * g1.z, v[j * 8 + 7] * rs * g1.w);
            *(u32x4*)(YMIX + (size_t)t * DM + ch) = o; }
    }
}

typedef float f32x16r __attribute__((ext_vector_type(16)));
__device__ __forceinline__ void p5_route(Frame& F, const Args& a, bool commit) {
    unsigned char* ws = a.ws;
    const float* H1 = a.out; const float* gm = a.in[I_NORM_MOE]; float* RS = (float*)(ws + WS_RS);
    const float* wg = a.in[I_W_GROUP]; const float* bg = a.in[I_B_GROUP]; const float* wr = a.in[I_W_ROUTER]; const float* br = a.in[I_B_ROUTER];
    int* LIST = (int*)(ws + WS_LIST); float* WTOP = (float*)(ws + WS_WTOP); unsigned* cnt = (unsigned*)(ws + WS_CTL) + CW_CNT;
    LAS float* red = (LAS float*)(F.lds + RING_OFF);
    LAS float* redg = red + 8 * 32 * 33;
    LAS float* redss = redg + 8 * 32 * 4;
    LAS float* fin = redss + 8 * 32;
    const int lane = F.lane, w = F.wave, i = lane & 31, kk = lane >> 5;
    for (int c = F.vcu; c < T_TOK / 32; c += F.G) {
        const int t0 = c * 32;
        const float* hrow = H1 + (size_t)(t0 + i) * DM + 256 * w + 4 * kk;
        f32x16r acc = {0.f, 0.f, 0.f, 0.f, 0.f, 0.f, 0.f, 0.f, 0.f, 0.f, 0.f, 0.f, 0.f, 0.f, 0.f, 0.f};
        float ss = 0.f; f32x4 g4 = {0.f, 0.f, 0.f, 0.f};
#pragma unroll 4
        for (int s = 0; s < 32; ++s) {
            const int kb = 256 * w + 8 * s + 4 * kk;
            const f32x4 h = *(const f32x4*)(hrow + 8 * s); const f32x4 gk = *(const f32x4*)(gm + kb);
            ss += (h.x * h.x + h.y * h.y) + (h.z * h.z + h.w * h.w);
            const f32x4 av = h * gk;
#pragma unroll
            for (int q = 0; q < 4; ++q) { const float bq = wr[(size_t)(kb + q) * NE + i]; const f32x4 wgk = *(const f32x4*)(wg + (size_t)(kb + q) * 4);
                acc = __builtin_amdgcn_mfma_f32_32x32x2f32(av[q], bq, acc, 0, 0, 0); g4 += wgk * av[q]; }
        }
        ss += __shfl_xor(ss, 32);
#pragma unroll
        for (int q = 0; q < 4; ++q) g4[q] += __shfl_xor(g4[q], 32);
#pragma unroll
        for (int r = 0; r < 16; ++r) red[(w * 32 + (r & 3) + 8 * (r >> 2) + 4 * kk) * 33 + i] = acc[r];
        if (kk == 0) { redss[w * 32 + i] = ss;
#pragma unroll
            for (int q = 0; q < 4; ++q) redg[(w * 32 + i) * 4 + q] = g4[q]; }
        __syncthreads();
        {
            const int ti = F.tid >> 4, jq = F.tid & 15; float s0 = 0.f, s1 = 0.f, s2 = 0.f;
#pragma unroll
            for (int ww = 0; ww < 8; ++ww) { s0 += red[(ww * 32 + ti) * 33 + jq]; s1 += red[(ww * 32 + ti) * 33 + jq + 16];
                if (jq < 4) s2 += redg[(ww * 32 + ti) * 4 + jq]; else if (jq == 4) s2 += redss[ww * 32 + ti]; }
            fin[ti * 40 + jq] = s0; fin[ti * 40 + jq + 16] = s1; if (jq < 5) fin[ti * 40 + 32 + jq] = s2;
        }
        __syncthreads();
        if (F.tid < 32) {
            const int t = t0 + F.tid; const LAS float* f = fin + F.tid * 40;
            const float rs = 1.0f / sqrtf(f[36] * (1.f / DM) + EPS);
            float gl[4];
#pragma unroll
            for (int g = 0; g < 4; ++g) gl[g] = f[32 + g] * rs + bg[g];
            int gsel = 0; float gmax = gl[0];
#pragma unroll
            for (int g = 1; g < 4; ++g) if (gl[g] > gmax) { gmax = gl[g]; gsel = g; }
            float gsum = 0.f;
#pragma unroll
            for (int g = 0; g < 4; ++g) gsum += __expf(gl[g] - gmax);
            const float pg = 1.f / gsum;
            float el[8];
#pragma unroll
            for (int j = 0; j < 8; ++j) el[j] = f[gsel * 8 + j] * rs + br[gsel * 8 + j];
            int i0 = 0; float v0 = el[0];
#pragma unroll
            for (int j = 1; j < 8; ++j) if (el[j] > v0) { v0 = el[j]; i0 = j; }
            int i1 = -1; float v1 = -INFINITY;
#pragma unroll
            for (int j = 0; j < 8; ++j) if (j != i0 && el[j] > v1) { v1 = el[j]; i1 = j; }
            const float ex = __expf(v1 - v0); const float w0 = pg / (1.f + ex), w1 = pg * ex / (1.f + ex);
            if (commit) {
                RS[t] = rs;
                const int e0 = gsel * 8 + i0, e1 = gsel * 8 + i1;
                const unsigned p0 = atomicAdd(cnt + e0, 1u); LIST[e0 * T_TOK + p0] = 2 * t; WTOP[2 * t] = w0;
                const unsigned p1 = atomicAdd(cnt + e1, 1u); LIST[e1 * T_TOK + p1] = 2 * t + 1; WTOP[2 * t + 1] = w1;
            }
        }
        __syncthreads();
    }
}

__device__ __forceinline__ void p6_gather(Frame& F, const Args& a) {
    unsigned char* ws = a.ws;
    const float* H1 = a.out; const float* gm = a.in[I_NORM_MOE]; const float* RS = (const float*)(ws + WS_RS);
    bf16* XS = (bf16*)(ws + WS_XS); const int* LIST = (const int*)(ws + WS_LIST); int* ROWTOK = (int*)(ws + WS_ROWTOK);
    unsigned* cnt = (unsigned*)(ws + WS_CTL) + CW_CNT;
    volatile LAS int* toff = (volatile LAS int*)(F.MISC + 16);
    volatile LAS int* ecnt = (volatile LAS int*)(F.MISC + 56);
    if (F.tid == 0) { int acc = 0; for (int e = 0; e < NE; ++e) { const int c = (int)__hip_atomic_load(cnt + e, RLX_AGENT); toff[e] = acc; ecnt[e] = c; acc += (c + 255) >> 8; } toff[NE] = acc; }
    __syncthreads();
    const int ntile = toff[NE];
    const int gw = F.vcu * NWAVES + F.wave, NGW = F.G * NWAVES, lane = F.lane;
    f32x4 gg[8];
#pragma unroll
    for (int j = 0; j < 8; ++j) gg[j] = ((const f32x4*)gm)[lane + 64 * j];
    for (int r = gw; r < ntile * 256; r += NGW) {
        const int tile = r >> 8; int e = 0;
#pragma unroll 1
        for (int j = 1; j < NE; ++j) if (toff[j] <= tile) e = j;
        const int pos = r - toff[e] * 256;
        u32x2* dst = (u32x2*)(XS + (size_t)r * DM) + lane;
        if (pos < ecnt[e]) { const int tk = LIST[e * T_TOK + pos]; const int tok = tk >> 1; const f32x4* src = (const f32x4*)(H1 + (size_t)tok * DM) + lane; const float rs = RS[tok];
#pragma unroll
            for (int j = 0; j < 8; ++j) { const f32x4 v = src[64 * j]; u32x2 o; o.x = pk2(v.x * rs * gg[j].x, v.y * rs * gg[j].y); o.y = pk2(v.z * rs * gg[j].z, v.w * rs * gg[j].w); dst[64 * j] = o; }
            if (lane == 0) ROWTOK[r] = tk; }
        else { const u32x2 z = {0u, 0u};
#pragma unroll
            for (int j = 0; j < 8; ++j) dst[64 * j] = z;
            if (lane == 0) ROWTOK[r] = -1; }
    }
}

__device__ __forceinline__ void p9_rows(Frame& F, const Args& a) {
    unsigned char* ws = a.ws;
    float* H = a.out; const bf16* Y = (const bf16*)(ws + WS_R2); bf16* HN = (bf16*)(ws + WS_R1); const float* gp = a.in[I_NORM_PLE];
    const int gw = F.vcu * NWAVES + F.wave, NGW = F.G * NWAVES, lane = F.lane;
    for (int t = gw; t < T_TOK; t += NGW) {
        f32x4* xr = (f32x4*)(H + (size_t)t * DM) + lane; const f32x4* gr = (const f32x4*)gp + lane;
        const u32x2* y0 = (const u32x2*)(Y + (size_t)(2 * t) * DM) + lane; const u32x2* y1 = (const u32x2*)(Y + (size_t)(2 * t + 1) * DM) + lane;
        f32x4 v[8]; float s = 0.f;
#pragma unroll
        for (int j = 0; j < 8; ++j) { v[j] = xr[64 * j]; const u32x2 a0 = y0[64 * j], a1 = y1[64 * j];
            v[j].x += bflo(a0.x) + bflo(a1.x); v[j].y += bfhi(a0.x) + bfhi(a1.x); v[j].z += bflo(a0.y) + bflo(a1.y); v[j].w += bfhi(a0.y) + bfhi(a1.y);
            xr[64 * j] = v[j]; s += (v[j].x * v[j].x + v[j].y * v[j].y) + (v[j].z * v[j].z + v[j].w * v[j].w); }
        const float rs = 1.0f / sqrtf(wave_sum(s) * (1.f / DM) + EPS);
        u32x2* o8 = (u32x2*)(HN + (size_t)t * DM) + lane;
#pragma unroll
        for (int j = 0; j < 8; ++j) { const f32x4 gg = gr[64 * j]; u32x2 w; w.x = pk2(v[j].x * rs * gg.x, v[j].y * rs * gg.y); w.y = pk2(v[j].z * rs * gg.z, v[j].w * rs * gg.w); o8[64 * j] = w; }
    }
}

#ifndef PHASE_MASK
#define PHASE_MASK 0xFFFF
#endif
#define PHASE_ON(k) (((PHASE_MASK) >> (k)) & 1)
#ifndef DUP_MASK
#define DUP_MASK 0
#endif
#define NREP(k) (PHASE_ON(k) ? 1 + (((DUP_MASK) >> (k)) & 1) : 0)

template <class Epi, class Sched>
__device__ __forceinline__ void run_gemm(LAS unsigned char* lds, const pg8::Gemm g, const Sched& S, const Epi& E) {
#if USE_PG8
    pg8::gemm_phase<Epi, Sched, false, true>(lds, g, S, E);
#else
    pg8::gemm_simple<Epi, Sched>(g, S, E);
    __syncthreads();
#endif
}

__global__ void __launch_bounds__(NWAVES * 64, 2) mega_fwd(Args args) {
    extern __shared__ __attribute__((aligned(16))) unsigned char lds[];
    Frame F;
    F.lds = (LAS unsigned char*)lds;
    F.MISC = (volatile LAS unsigned*)(F.lds + MISC_OFF);
    F.tid = threadIdx.x; F.lane = F.tid & 63; F.wave = __builtin_amdgcn_readfirstlane(F.tid >> 6);
    F.G = gridDim.x; { const int bx = blockIdx.x; F.vcu = (F.G % 8 == 0) ? (bx % 8) * (F.G / 8) + bx / 8 : bx; }
    unsigned char* ws = args.ws;
    F.ctl = (gu32*)(ws + WS_CTL);
    for (int u = F.tid; u < (LDS_BYTES - LDSCTL_OFF) / 4; u += NWAVES * 64) ((LAS unsigned*)(F.lds + LDSCTL_OFF))[u] = 0u;
    __syncthreads();
    XcdBarrier bar = xcd_barrier_post((unsigned*)(F.ctl + CW_BAR), F.MISC + 8);
#define GRID_BAR() xcd_barrier(bar)
    const int G = F.G, bx = (int)blockIdx.x;

    for (int rep = 0; rep < NREP(0); ++rep) {
    p0_prologue(F, args);
    GRID_BAR();

    }
    for (int rep = 0; rep < NREP(1); ++rep) {
    {
        pg8::Gemm g{(const bf16*)(ws + WS_R1), (const bf16*)(ws + WS_WIN), T_TOK, DINP, DM}; pg8::StaticOrder S; S.init(T_TOK, DINP, G, bx);
        EpiBf16Plain E{(bf16*)(ws + WS_R2), DINP};
        run_gemm(F.lds + RING_OFF, g, S, E);
    }
    {
        pg8::Gemm g{(const bf16*)(ws + WS_PB), (const bf16*)(ws + WS_WPLE), T_TOK, DM, PLE}; pg8::StaticOrder S; S.init(T_TOK, DM, G, bx);
        EpiBf16Plain E{(bf16*)(ws + WS_PE), DM};
        run_gemm(F.lds + RING_OFF, g, S, E);
    }
    GRID_BAR();

    }
    for (int rep = 0; rep < NREP(2); ++rep) {
    p2a_rows(F, args);
    GRID_BAR();

    }
    for (int rep = 0; rep < NREP(3); ++rep) {
    {
        pg8::Gemm g{(const bf16*)(ws + WS_QLN), (const bf16*)(ws + WS_WUQ), T_TOK, DM, QR}; pg8::StaticOrder S; S.init(T_TOK, DM, G, bx);
        EpiBf16Plain E{(bf16*)(ws + WS_R1), DM};
        run_gemm(F.lds + RING_OFF, g, S, E);
    }
    {
        pg8::Gemm g{(const bf16*)(ws + WS_KVLN), (const bf16*)(ws + WS_WUKV), T_TOK, DM, KVR}; pg8::StaticOrder S; S.init(T_TOK, DM, G, bx);
        EpiBf16Plain E{(bf16*)(ws + WS_KVRAW), DM};
        run_gemm(F.lds + RING_OFF, g, S, E);
    }
    GRID_BAR();

    }
    for (int rep = 0; rep < NREP(4); ++rep) {
    p2c_qk(F, args);
    GRID_BAR();

    }
    for (int rep = 0; rep < NREP(5); ++rep) {
    {
        const bf16* Q = (const bf16*)(ws + WS_Q); const bf16* K = (const bf16*)(ws + WS_K); const bf16* KVRAW = (const bf16*)(ws + WS_KVRAW); bf16* O = (bf16*)(ws + WS_R2);
        for (int u = F.vcu; u < 256; u += G) {
            const int bh = u >> 4, qb = u & 15, b = bh >> 3, h = bh & 7;
            att::attn_unit(Q + ((size_t)bh * SEQ + qb * 256) * QKH, K + (size_t)bh * SEQ * QKH, KVRAW + (size_t)b * SEQ * DM + h * 256 + 128,
                           O + ((size_t)b * SEQ + qb * 256) * 1024 + h * 128, qb, (char*)lds + RING_OFF);
        }
        if (rep == 0) moe_convert_dyn(F, args);
    }
    GRID_BAR();

    }
    for (int rep = 0; rep < NREP(6); ++rep) {
    p3b_rows(F, args);
    GRID_BAR();

    }
    for (int rep = 0; rep < NREP(7); ++rep) {
    {
        pg8::Gemm g{(const bf16*)(ws + WS_R4), (const bf16*)(ws + WS_WOUT), T_TOK, DM, DM}; pg8::StaticOrder S; S.init(T_TOK, DM, G, bx);
        EpiResF32 E{args.in[I_X], args.out, DM};
        run_gemm(F.lds + RING_OFF, g, S, E);
    }
    GRID_BAR();

    }
    for (int rep = 0; rep < NREP(8); ++rep) {
    p5_route(F, args, rep == 0);
    GRID_BAR();

    }
    for (int rep = 0; rep < NREP(9); ++rep) {
    p6_gather(F, args);
    GRID_BAR();

    }
    for (int rep = 0; rep < NREP(10); ++rep) {
    {
        pg8::Gemm g{(const bf16*)(ws + WS_XS), (const bf16*)(ws + WS_W13), MAXROWS, 1024, DM};
        pg8::MoeOrder S{(const volatile LAS int*)(F.MISC + 16), 4, G, bx};
        EpiSwiGLU E{(bf16*)(ws + WS_R4)};
        run_gemm(F.lds + RING_OFF, g, S, E);
    }
    GRID_BAR();

    }
    for (int rep = 0; rep < NREP(11); ++rep) {
    {
        pg8::Gemm g{(const bf16*)(ws + WS_R4), (const bf16*)(ws + WS_W2), MAXROWS, DM, DE};
        pg8::MoeOrder S{(const volatile LAS int*)(F.MISC + 16), 8, G, bx};
        EpiMoeOut E{(bf16*)(ws + WS_R2), (const int*)(ws + WS_ROWTOK), (const float*)(ws + WS_WTOP)};
        run_gemm(F.lds + RING_OFF, g, S, E);
    }
    GRID_BAR();

    }
    for (int rep = 0; rep < NREP(12); ++rep) {
    p9_rows(F, args);
    GRID_BAR();

    }
    for (int rep = 0; rep < NREP(13); ++rep) {
    {
        pg8::Gemm g{(const bf16*)(ws + WS_R1), (const bf16*)(ws + WS_WPG), T_TOK, DM, DM}; pg8::StaticOrder S; S.init(T_TOK, DM, G, bx);
        EpiGate E{args.out, (const bf16*)(ws + WS_PE), args.in[I_B_PLE_GATE]};
        run_gemm(F.lds + RING_OFF, g, S, E);
    }
}
    }

extern "C" void kernel_launch(void* const* d_in, const int* in_sizes, int n_in, void* d_out, int out_size, void* d_ws, size_t ws_size, hipStream_t stream) {
    static int grid = 0;
    if (grid == 0) {
        if (n_in != 27 || out_size != T_TOK * DM || ws_size < WS_END) { fprintf(stderr, "kernel_launch: unexpected shapes: n_in %d out %d ws %zu (need %zu)\n", n_in, out_size, ws_size, (size_t)WS_END); grid = -1; return; }
        int dev = 0, cus = 0, per_cu = 0;
        if (hipGetDevice(&dev) != hipSuccess || hipDeviceGetAttribute(&cus, hipDeviceAttributeMultiprocessorCount, dev) != hipSuccess) { grid = -1; return; }
        if (hipFuncSetAttribute((const void*)mega_fwd, hipFuncAttributeMaxDynamicSharedMemorySize, LDS_BYTES) != hipSuccess) { fprintf(stderr, "kernel_launch: hipFuncSetAttribute failed\n"); grid = -1; return; }
        if (hipOccupancyMaxActiveBlocksPerMultiprocessor(&per_cu, (const void*)mega_fwd, NWAVES * 64, LDS_BYTES) != hipSuccess || per_cu < 1)
            fprintf(stderr, "kernel_launch: note: occupancy query reports %d\n", per_cu);
        (void)hipGetLastError();
        grid = cus;
    }
    if (grid < 0) return;
    if (hipMemsetAsync((char*)d_ws + WS_CTL, 0, CTL_ZERO_BYTES, stream) != hipSuccess) { fprintf(stderr, "kernel_launch: memset failed\n"); return; }
    Args a{};
    for (int i = 0; i < 27; ++i) a.in[i] = (const float*)d_in[i];
    a.out = (float*)d_out; a.ws = (unsigned char*)d_ws;
    for (int i = 0; i < 32; ++i) a.freq[i] = powf(10000.0f, -(float)(2 * i) / 64.0f);
    hipLaunchKernelGGL(mega_fwd, dim3(grid), dim3(NWAVES * 64), LDS_BYTES, stream, a);
    const hipError_t le = hipPeekAtLastError();
    if (le != hipSuccess) fprintf(stderr, "kernel_launch: launch failed: %s\n", hipGetErrorName(le));
}
```

```cpp
#include <hip/hip_runtime.h>
#include <cstdio>
#include <cstdint>
#include <cmath>

#ifndef USE_PG8
#define USE_PG8 1
#endif

#define GAS __attribute__((address_space(1)))
#define LAS __attribute__((address_space(3)))
typedef unsigned short bf16;
typedef short bf16x8 __attribute__((ext_vector_type(8)));
typedef short s16x4 __attribute__((ext_vector_type(4)));
typedef float f32x4 __attribute__((ext_vector_type(4)));
typedef float f32x16 __attribute__((ext_vector_type(16)));
typedef unsigned u32x4 __attribute__((ext_vector_type(4)));
typedef unsigned u32x2 __attribute__((ext_vector_type(2)));
typedef GAS unsigned gu32;

constexpr int T_TOK = 8192, SEQ = 4096, DM = 2048, DIN = 3904, DINP = 4096;
constexpr int QR = 512, KVR = 256, ROPE = 64, DC = 1024, NH = 8, QKH = 192, VH = 128;
constexpr int NE = 32, DE = 512, PLE = 256;
constexpr int OFF_QLAT = 0, OFF_KVLAT = 512, OFF_KROPE = 768, OFF_B = 832, OFF_C = 1856, OFF_H = 2880;
constexpr float EPS = 1e-6f;
constexpr int MAXROWS = 24576;

constexpr size_t MiB = 1u << 20;
constexpr size_t WS_CTL = 0, CTL_ZERO_BYTES = 1 * MiB;
constexpr size_t WS_CS = 1 * MiB;
constexpr size_t WS_WTOP = 3 * MiB;
constexpr size_t WS_ROWTOK = 3 * MiB + 256 * 1024;
constexpr size_t WS_RS = 3 * MiB + 512 * 1024;
constexpr size_t WS_LIST = 4 * MiB;
constexpr size_t WS_WIN = 5 * MiB;
constexpr size_t WS_WUQ = 21 * MiB;
constexpr size_t WS_WUKV = 23 * MiB;
constexpr size_t WS_WPLE = 24 * MiB;
constexpr size_t WS_WOUT = 25 * MiB;
constexpr size_t WS_WPG = 33 * MiB;
constexpr size_t WS_W13 = 41 * MiB;
constexpr size_t WS_W2 = 169 * MiB;
constexpr size_t WS_R1 = 233 * MiB;
constexpr size_t WS_R2 = 265 * MiB;
constexpr size_t WS_PE = 329 * MiB;
constexpr size_t WS_R4 = 361 * MiB;
constexpr size_t WS_KVRAW = 393 * MiB;
constexpr size_t WS_Q = 425 * MiB;
constexpr size_t WS_K = 449 * MiB;
constexpr size_t WS_QLN = 473 * MiB;
constexpr size_t WS_KVLN = 481 * MiB;
constexpr size_t WS_PB = 485 * MiB;
constexpr size_t WS_XS = 393 * MiB;
constexpr size_t WS_END = 489 * MiB;
constexpr int CW_TMO = 0, CW_CODE = 1, CW_BAR = 4096, CW_CNT = 16384, CW_QCONV = 16512;

constexpr int RING_OFF = 0, RING_BYTES = 131072;
constexpr int LDSCTL_OFF = RING_BYTES, MISC_OFF = LDSCTL_OFF + 320;
constexpr int LDS_BYTES = 147456;
constexpr int NWAVES = 8;

#define LDS_WAIT() asm volatile("s_waitcnt lgkmcnt(0)" ::: "memory")
#define VM_WAIT() asm volatile("s_waitcnt vmcnt(0)" ::: "memory")
#define RLX_AGENT __ATOMIC_RELAXED, __HIP_MEMORY_SCOPE_AGENT

__device__ __forceinline__ unsigned f2bf(float f) { unsigned u = __builtin_bit_cast(unsigned, f); return (u + 0x7fffu + ((u >> 16) & 1u)) >> 16; }
__device__ __forceinline__ unsigned pk2(float lo, float hi) { return f2bf(lo) | (f2bf(hi) << 16); }
__device__ __forceinline__ float bf2f(unsigned short b) { return __builtin_bit_cast(float, (unsigned)b << 16); }
__device__ __forceinline__ float bflo(unsigned w) { return __builtin_bit_cast(float, w << 16); }
__device__ __forceinline__ float bfhi(unsigned w) { return __builtin_bit_cast(float, w & 0xffff0000u); }
__device__ __forceinline__ float wave_sum(float v) {
#pragma unroll
    for (int o = 1; o < 64; o <<= 1) v += __shfl_xor(v, o);
    return v;
}

namespace pg8 {
#define PG8_LAS __attribute__((address_space(3)))
typedef unsigned short bf16_t;
constexpr int BM = 256, BK = 64, HALF = 128, HTB = HALF * BK * 2, STAGE_BYTES = 8 * HTB, NXCD = 8, WGM = 8;
__host__ __device__ __forceinline__ int lds_byte(int r, int c) { const int st = (r >> 4) * 2 + (c >> 5), rr = r & 15, cc = c & 31, ob = rr * 64 + cc * 2; return st * 1024 + (ob ^ (((ob >> 9) & 1) << 5)); }
__host__ __device__ __forceinline__ void stage_rc(int b, int& R, int& C) { const int st = b / 1024, sb = b % 1024, swz = sb ^ (((sb >> 9) & 1) << 5); R = (st >> 1) * 16 + swz / 64; C = (st & 1) * 32 + (swz % 64) / 2; }
__host__ __device__ __forceinline__ int perm32(int rho) { const int n = rho >> 4, i = rho & 15; return 8 * (i >> 2) + 4 * n + (i & 3); }

struct Unit { int pm, pn, pb; };
struct Gemm { const bf16_t* A; const bf16_t* Bt; int M, N, K; };

struct StaticOrder {
    int nM, nN, nwg, G, c;
    __host__ __device__ void init(int M, int N, int G_, int c_) { nM = M / BM; nN = N / BM; nwg = nM * nN; G = G_; c = c_; }
    __host__ __device__ bool next(int i, Unit& u) const {
        const long L = (long)i * G + c; if (L >= nwg) return false;
        int wgid = (int)L; { const int q = nwg / NXCD, r = nwg % NXCD, xcd = wgid % NXCD, off = wgid / NXCD; wgid = (xcd < r ? xcd * (q + 1) : r * (q + 1) + (xcd - r) * q) + off; }
        const int nig = WGM * nN, gid = wgid / nig, fm = gid * WGM, gsz = (nM - fm) < WGM ? (nM - fm) : WGM;
        u.pm = fm + ((wgid % nig) % gsz); u.pn = (wgid % nig) / gsz; u.pb = u.pn; return true;
    }
    __device__ __forceinline__ void a_ready(const Unit&) const {}
    __device__ __forceinline__ void done(const Unit&) const {}
};
struct MoeOrder {
    const volatile LAS int* toff; int NPN, G, c;
    __device__ __forceinline__ bool next(int i, Unit& u) const {
        const int L = i * G + c; const int nt = toff[NE];
        if (L >= nt * NPN) return false;
        const int tile = L / NPN, pn = L - tile * NPN; int e = 0;
#pragma unroll 1
        for (int j = 1; j < NE; ++j) if (toff[j] <= tile) e = j;
        u.pm = tile; u.pn = pn; u.pb = e * NPN + pn; return true;
    }
    __device__ __forceinline__ void a_ready(const Unit&) const {}
    __device__ __forceinline__ void done(const Unit&) const {}
};

template <class Epi, class Sched>
__device__ __forceinline__ void gemm_simple(const Gemm g, const Sched& S, const Epi& E) {
    const int tid = threadIdx.x, wid = __builtin_amdgcn_readfirstlane(tid >> 6), lane = tid & 63, wr = wid >> 2, wc = wid & 3, fr = lane & 15, fq = lane >> 4;
    const int K = g.K;
    Unit u;
    for (int i = 0; S.next(i, u); ++i) {
        f32x4 acc[2][2][4][2];
#pragma unroll
        for (int a = 0; a < 2; ++a)
#pragma unroll
            for (int b = 0; b < 2; ++b)
#pragma unroll
                for (int m = 0; m < 4; ++m)
#pragma unroll
                    for (int n = 0; n < 2; ++n) acc[a][b][m][n] = (f32x4){0.f, 0.f, 0.f, 0.f};
        const bf16_t* Ab = g.A + (size_t)(u.pm * BM + wr * 64 + fr) * K + fq * 8;
        const bf16_t* Bb = g.Bt + (size_t)(u.pb * BM + wc * 32 + fr) * K + fq * 8;
#pragma unroll 1
        for (int k0 = 0; k0 < K; k0 += 32) {
            bf16x8 a[2][4], b[2][2];
#pragma unroll
            for (int ai = 0; ai < 2; ++ai)
#pragma unroll
                for (int m = 0; m < 4; ++m) a[ai][m] = *(const bf16x8*)(Ab + (size_t)(ai * HALF + m * 16) * K + k0);
#pragma unroll
            for (int bj = 0; bj < 2; ++bj)
#pragma unroll
                for (int n = 0; n < 2; ++n) b[bj][n] = *(const bf16x8*)(Bb + (size_t)(bj * HALF + n * 16) * K + k0);
#pragma unroll
            for (int ai = 0; ai < 2; ++ai)
#pragma unroll
                for (int bj = 0; bj < 2; ++bj)
#pragma unroll
                    for (int m = 0; m < 4; ++m)
#pragma unroll
                        for (int n = 0; n < 2; ++n) acc[ai][bj][m][n] = __builtin_amdgcn_mfma_f32_16x16x32_bf16(b[bj][n], a[ai][m], acc[ai][bj][m][n], 0, 0, 0);
        }
        E(acc, u, wr, wc, fr, fq);
    }
}
template <class Epi, class Sched, bool ALIGN_EPI = false, bool SP2 = false>
__device__ __forceinline__ void gemm_phase(PG8_LAS unsigned char* lds, const Gemm g, const Sched& S, const Epi& E) {
    int tid_ = threadIdx.x; asm volatile("" : "+v"(tid_));
    const int tid = tid_, wid = __builtin_amdgcn_readfirstlane(tid >> 6), lane = tid & 63, wr = wid >> 2, wc = wid & 3, fr = lane & 15, fq = lane >> 4;
    const int K = g.K, nt = K / BK;
    unsigned voffA[2], voffB[2];
#pragma unroll
    for (int i = 0; i < 2; ++i) { int R, C; stage_rc(tid * 16 + i * 8192, R, C); const int Rb = Epi::PERM ? ((R & ~31) + perm32(R & 31)) : R;
        voffA[i] = (unsigned)(R * K + C) * 2u; voffB[i] = (unsigned)(Rb * K + C) * 2u; }
    const size_t kstep = (size_t)(BK * 2);
    const size_t hstep = (size_t)HALF * K * 2;
    const size_t tstep = 2 * hstep;
    const unsigned ldsw = (unsigned)wid * 1024u;
    const int aoff = lds_byte(wr * 64 + fr, fq * 8), boff = lds_byte(wc * 32 + fr, fq * 8);
#define PG8_SA(b, h) (((b) * 2 + (h)) * HTB)
#define PG8_SB(b, h) ((4 + (b) * 2 + (h)) * HTB)
#define PG8_STAGE(bufoff, gbase, voff) do { _Pragma("unroll") for (int _i = 0; _i < 2; ++_i) \
        __builtin_amdgcn_global_load_lds((const unsigned*)((const char*)(gbase) + (voff)[_i]), (PG8_LAS unsigned*)(lds + (bufoff) + ldsw + _i * 8192), 16, 0, 0); } while (0)
#define PG8_LDA(dst, b, h) do { _Pragma("unroll") for (int m = 0; m < 4; ++m) _Pragma("unroll") for (int k = 0; k < 2; ++k) dst[m][k] = *(const PG8_LAS bf16x8*)(lds + PG8_SA(b, h) + aoff + m * 2048 + k * 1024); } while (0)
#define PG8_LDB(dst, b, h) do { _Pragma("unroll") for (int n = 0; n < 2; ++n) _Pragma("unroll") for (int k = 0; k < 2; ++k) dst[n][k] = *(const PG8_LAS bf16x8*)(lds + PG8_SB(b, h) + boff + n * 2048 + k * 1024); } while (0)
#define PG8_MMA(ai, bj, At, Bt) do { __builtin_amdgcn_s_setprio(1); _Pragma("unroll") for (int m = 0; m < 4; ++m) _Pragma("unroll") for (int n = 0; n < 2; ++n) _Pragma("unroll") for (int k = 0; k < 2; ++k) \
        acc[ai][bj][m][n] = __builtin_amdgcn_mfma_f32_16x16x32_bf16(Bt[n][k], At[m][k], acc[ai][bj][m][n], 0, 0, 0); __builtin_amdgcn_s_setprio(0); } while (0)
#define PG8_WAIT_V(n) asm volatile("s_waitcnt vmcnt(" #n ")" ::: "memory")
#define PG8_WAIT_L(n) asm volatile("s_waitcnt lgkmcnt(" #n ")" ::: "memory")
#define PG8_BAR __builtin_amdgcn_s_barrier()
#define PG8_SCHED __builtin_amdgcn_sched_barrier(0)
    Unit cur, nxt; int ui = 0;
    if (!S.next(0, cur)) return;
    f32x4 acc[2][2][4][2];
#pragma unroll
    for (int a = 0; a < 2; ++a)
#pragma unroll
        for (int b = 0; b < 2; ++b)
#pragma unroll
            for (int m = 0; m < 4; ++m)
#pragma unroll
                for (int n = 0; n < 2; ++n) acc[a][b][m][n] = (f32x4){0.f, 0.f, 0.f, 0.f};
    bf16x8 At[4][2], B0[2][2], B1[2][2];
    const char* cA = (const char*)g.A + (size_t)cur.pm * tstep; const char* cB = (const char*)g.Bt + (size_t)cur.pb * tstep;
    S.a_ready(cur);
    if constexpr (SP2) {
        PG8_STAGE(PG8_SB(0, 0), cB, voffB); PG8_STAGE(PG8_SB(0, 1), cB + hstep, voffB); PG8_STAGE(PG8_SA(0, 0), cA, voffA); PG8_STAGE(PG8_SA(0, 1), cA + hstep, voffA);
        if (wr == 1) PG8_BAR;
        PG8_WAIT_V(2); PG8_BAR;
        PG8_STAGE(PG8_SB(1, 0), cB + kstep, voffB); PG8_STAGE(PG8_SA(1, 0), cA + kstep, voffA); PG8_STAGE(PG8_SB(1, 1), cB + hstep + kstep, voffB);
        PG8_WAIT_V(6); PG8_BAR;
    } else {
        PG8_STAGE(PG8_SB(0, 0), cB, voffB); PG8_STAGE(PG8_SA(0, 0), cA, voffA); PG8_STAGE(PG8_SB(0, 1), cB + hstep, voffB); PG8_STAGE(PG8_SA(0, 1), cA + hstep, voffA);
        if (wr == 1) PG8_BAR;
        PG8_WAIT_V(4); PG8_BAR;
        PG8_STAGE(PG8_SB(1, 0), cB + kstep, voffB); PG8_STAGE(PG8_SA(1, 0), cA + kstep, voffA); PG8_STAGE(PG8_SB(1, 1), cB + hstep + kstep, voffB);
        PG8_WAIT_V(6); PG8_BAR;
    }
    for (;;) {
        const bool has_next = S.next(ui + 1, nxt);
        const char* nA = has_next ? (const char*)g.A + (size_t)nxt.pm * tstep : cA; const char* nB = has_next ? (const char*)g.Bt + (size_t)nxt.pb * tstep : cB;
        for (int t = 0; t < nt; t += 2) {
            const bool last = (t == nt - 2);
            const char* a1 = cA + (size_t)(t + 1) * kstep;
            const char* a2 = last ? nA : cA + (size_t)(t + 2) * kstep; const char* b2 = last ? nB : cB + (size_t)(t + 2) * kstep;
            const char* a3 = a2 + kstep; const char* b3 = b2 + kstep;
            if (last && has_next) S.a_ready(nxt);
            if constexpr (SP2) {
            PG8_LDB(B0, 0, 0); PG8_LDB(B1, 0, 1); PG8_SCHED; PG8_LDA(At, 0, 0); PG8_STAGE(PG8_SA(1, 1), a1 + hstep, voffA);
            PG8_WAIT_V(8); PG8_WAIT_L(0); PG8_BAR; PG8_MMA(0, 0, At, B0); PG8_MMA(0, 1, At, B1); PG8_BAR; PG8_SCHED;
            PG8_LDA(At, 0, 1); PG8_STAGE(PG8_SB(0, 0), b2, voffB); PG8_STAGE(PG8_SB(0, 1), b2 + hstep, voffB); PG8_STAGE(PG8_SA(0, 0), a2, voffA);
            PG8_WAIT_V(8); PG8_WAIT_L(0); PG8_BAR; PG8_MMA(1, 0, At, B0); PG8_MMA(1, 1, At, B1); PG8_BAR; PG8_SCHED;
            PG8_LDB(B0, 1, 0); PG8_LDB(B1, 1, 1); PG8_SCHED; PG8_LDA(At, 1, 0); PG8_STAGE(PG8_SA(0, 1), a2 + hstep, voffA);
            PG8_WAIT_V(8); PG8_WAIT_L(0); PG8_BAR; PG8_MMA(0, 0, At, B0); PG8_MMA(0, 1, At, B1); PG8_BAR; PG8_SCHED;
            PG8_LDA(At, 1, 1); PG8_STAGE(PG8_SB(1, 0), b3, voffB); PG8_STAGE(PG8_SB(1, 1), b3 + hstep, voffB); PG8_STAGE(PG8_SA(1, 0), a3, voffA);
            PG8_WAIT_V(8); PG8_WAIT_L(0); PG8_BAR; PG8_MMA(1, 0, At, B0); PG8_MMA(1, 1, At, B1); PG8_BAR; PG8_SCHED;
            } else {
            PG8_LDB(B0, 0, 0); PG8_SCHED; PG8_LDA(At, 0, 0); PG8_STAGE(PG8_SA(1, 1), a1 + hstep, voffA);
            PG8_WAIT_L(8); PG8_BAR; PG8_WAIT_L(0); PG8_MMA(0, 0, At, B0); PG8_BAR; PG8_SCHED;
            PG8_LDB(B1, 0, 1); PG8_STAGE(PG8_SB(0, 0), b2, voffB);
            PG8_BAR; PG8_WAIT_L(0); PG8_MMA(0, 1, At, B1); PG8_BAR;
            PG8_LDA(At, 0, 1); PG8_STAGE(PG8_SA(0, 0), a2, voffA);
            PG8_BAR; PG8_WAIT_L(0); PG8_MMA(1, 0, At, B0); PG8_BAR; PG8_SCHED;
            PG8_STAGE(PG8_SB(0, 1), b2 + hstep, voffB);
            PG8_WAIT_V(6); PG8_BAR; PG8_MMA(1, 1, At, B1); PG8_BAR;
            PG8_LDB(B0, 1, 0); PG8_SCHED; PG8_LDA(At, 1, 0); PG8_STAGE(PG8_SA(0, 1), a2 + hstep, voffA);
            PG8_WAIT_L(8); PG8_BAR; PG8_WAIT_L(0); PG8_MMA(0, 0, At, B0); PG8_BAR; PG8_SCHED;
            PG8_LDB(B1, 1, 1); PG8_STAGE(PG8_SB(1, 0), b3, voffB);
            PG8_BAR; PG8_WAIT_L(0); PG8_MMA(0, 1, At, B1); PG8_BAR;
            PG8_LDA(At, 1, 1); PG8_STAGE(PG8_SA(1, 0), a3, voffA);
            PG8_BAR; PG8_WAIT_L(0); PG8_MMA(1, 0, At, B0); PG8_BAR; PG8_SCHED;
            PG8_STAGE(PG8_SB(1, 1), b3 + hstep, voffB);
            PG8_WAIT_V(6); PG8_BAR; PG8_MMA(1, 1, At, B1); PG8_BAR;
            }
        }
        if constexpr (ALIGN_EPI) { if (wr == 0) PG8_BAR; }
        if constexpr (!Epi::AFTER_DRAIN) { E(acc, cur, wr, wc, fr, fq); S.done(cur); }
        if (!has_next) break;
#pragma unroll
        for (int a = 0; a < 2; ++a)
#pragma unroll
            for (int b = 0; b < 2; ++b)
#pragma unroll
                for (int m = 0; m < 4; ++m)
#pragma unroll
                    for (int n = 0; n < 2; ++n) acc[a][b][m][n] = (f32x4){0.f, 0.f, 0.f, 0.f};
        cur = nxt; cA = nA; cB = nB; ++ui;
        if constexpr (ALIGN_EPI) { if (wr == 1) PG8_BAR; }
    }
    PG8_WAIT_V(0);
    if constexpr (!ALIGN_EPI) { if (wr == 0) PG8_BAR; }
    PG8_BAR;
    if constexpr (Epi::AFTER_DRAIN) { E.fused(acc, cur, wr, wc, fr, fq, lds, wid, lane); S.done(cur); }
#undef PG8_SA
#undef PG8_SB
#undef PG8_STAGE
#undef PG8_LDA
#undef PG8_LDB
#undef PG8_MMA
#undef PG8_WAIT_V
#undef PG8_WAIT_L
#undef PG8_BAR
#undef PG8_SCHED
}
}

typedef f32x4 AccT[2][2][4][2];
struct EpiBf16Plain {
    static constexpr bool PERM = false, AFTER_DRAIN = false;
    bf16* O; int ldc;
    __device__ __forceinline__ void operator()(const AccT& acc, const pg8::Unit& u, int wr, int wc, int fr, int fq) const {
        const int row0 = u.pm * 256 + wr * 64 + fr, col0 = u.pn * 256 + wc * 32 + 4 * fq;
#pragma unroll
        for (int ai = 0; ai < 2; ++ai)
#pragma unroll
            for (int m = 0; m < 4; ++m) { bf16* rowp = O + (size_t)(row0 + ai * 128 + m * 16) * ldc + col0;
#pragma unroll
                for (int bj = 0; bj < 2; ++bj)
#pragma unroll
                    for (int n = 0; n < 2; ++n) { const f32x4 v = acc[ai][bj][m][n]; u32x2 w; w.x = pk2(v[0], v[1]); w.y = pk2(v[2], v[3]); *(u32x2*)(rowp + bj * 128 + n * 16) = w; } }
    }
};
struct EpiResF32 {
    static constexpr bool PERM = false, AFTER_DRAIN = false;
    const float* base; float* out; int ldc;
    __device__ __forceinline__ void operator()(const AccT& acc, const pg8::Unit& u, int wr, int wc, int fr, int fq) const {
        const int row0 = u.pm * 256 + wr * 64 + fr, col0 = u.pn * 256 + wc * 32 + 4 * fq;
#pragma unroll
        for (int ai = 0; ai < 2; ++ai)
#pragma unroll
            for (int m = 0; m < 4; ++m) { const size_t off = (size_t)(row0 + ai * 128 + m * 16) * ldc + col0;
#pragma unroll
                for (int bj = 0; bj < 2; ++bj)
#pragma unroll
                    for (int n = 0; n < 2; ++n) { const f32x4 b = *(const f32x4*)(base + off + bj * 128 + n * 16); *(f32x4*)(out + off + bj * 128 + n * 16) = b + acc[ai][bj][m][n]; } }
    }
};
struct EpiSwiGLU {
    static constexpr bool PERM = false, AFTER_DRAIN = false;
    bf16* H;
    __device__ __forceinline__ void operator()(const AccT& acc, const pg8::Unit& u, int wr, int wc, int fr, int fq) const {
        const int row0 = u.pm * 256 + wr * 64 + fr;
#pragma unroll
        for (int ai = 0; ai < 2; ++ai)
#pragma unroll
            for (int m = 0; m < 4; ++m) { bf16* rowp = H + (size_t)(row0 + ai * 128 + m * 16) * DE;
#pragma unroll
                for (int bj = 0; bj < 2; ++bj) { const f32x4 a = acc[ai][bj][m][0], b = acc[ai][bj][m][1]; float h[4];
#pragma unroll
                    for (int r = 0; r < 4; ++r) h[r] = a[r] / (1.f + __expf(-a[r])) * b[r];
                    u32x2 w; w.x = pk2(h[0], h[1]); w.y = pk2(h[2], h[3]);
                    *(u32x2*)(rowp + 16 * (u.pn * 8 + 4 * bj + wc) + 4 * fq) = w; } }
    }
};
struct EpiMoeOut {
    static constexpr bool PERM = false, AFTER_DRAIN = false;
    bf16* Y; const int* rowtok; const float* wtop;
    __device__ __forceinline__ void operator()(const AccT& acc, const pg8::Unit& u, int wr, int wc, int fr, int fq) const {
        const int row0 = u.pm * 256 + wr * 64 + fr, col0 = u.pn * 256 + wc * 32 + 4 * fq;
#pragma unroll
        for (int ai = 0; ai < 2; ++ai)
#pragma unroll
            for (int m = 0; m < 4; ++m) { const int tk = rowtok[row0 + ai * 128 + m * 16];
                if (tk >= 0) { const float w = wtop[tk]; bf16* rowp = Y + (size_t)tk * DM + col0;
#pragma unroll
                    for (int bj = 0; bj < 2; ++bj)
#pragma unroll
                        for (int n = 0; n < 2; ++n) { const f32x4 v = acc[ai][bj][m][n] * w; u32x2 q; q.x = pk2(v[0], v[1]); q.y = pk2(v[2], v[3]); *(u32x2*)(rowp + bj * 128 + n * 16) = q; } } }
    }
};
struct EpiGate {
    static constexpr bool PERM = false, AFTER_DRAIN = false;
    float* out; const bf16* PE; const float* bias;
    __device__ __forceinline__ void operator()(const AccT& acc, const pg8::Unit& u, int wr, int wc, int fr, int fq) const {
        const int row0 = u.pm * 256 + wr * 64 + fr, col0 = u.pn * 256 + wc * 32 + 4 * fq;
        f32x4 bv[2][2];
#pragma unroll
        for (int bj = 0; bj < 2; ++bj)
#pragma unroll
            for (int n = 0; n < 2; ++n) bv[bj][n] = *(const f32x4*)(bias + col0 + bj * 128 + n * 16);
#pragma unroll
        for (int ai = 0; ai < 2; ++ai)
#pragma unroll
            for (int m = 0; m < 4; ++m) { const size_t off = (size_t)(row0 + ai * 128 + m * 16) * DM + col0;
#pragma unroll
                for (int bj = 0; bj < 2; ++bj)
#pragma unroll
                    for (int n = 0; n < 2; ++n) { const size_t o2 = off + bj * 128 + n * 16;
                        const f32x4 h2 = *(const f32x4*)(out + o2); const u32x2 pw = *(const u32x2*)(PE + o2); const f32x4 z = acc[ai][bj][m][n] + bv[bj][n];
                        f32x4 r; r[0] = h2[0] + bflo(pw.x) / (1.f + __expf(-z[0])); r[1] = h2[1] + bfhi(pw.x) / (1.f + __expf(-z[1]));
                        r[2] = h2[2] + bflo(pw.y) / (1.f + __expf(-z[2])); r[3] = h2[3] + bfhi(pw.y) / (1.f + __expf(-z[3]));
                        *(f32x4*)(out + o2) = r; } }
    }
};
#define XB_TMO      128
#define XB_XCNT(j)  (256  + 64 * (j))
#define XB_XSUB(j)  (1280 + 64 * (j))
#define XB_XGEN(j)  (2304 + 64 * (j))
#define XB_TOP      3328
#define XB_TOPGEN   3392
#define XCD_BAR_WORDS 3456
#define XB_SPIN_CAP (1u << 22)

__device__ __forceinline__ unsigned xb_ld(unsigned* p)              { return __hip_atomic_load(p, __ATOMIC_RELAXED, __HIP_MEMORY_SCOPE_AGENT); }
__device__ __forceinline__ unsigned xb_add(unsigned* p, unsigned v) { return __hip_atomic_fetch_add(p, v, __ATOMIC_RELAXED, __HIP_MEMORY_SCOPE_AGENT); }
__device__ __forceinline__ unsigned xb_xcc_id() { return (unsigned)__builtin_amdgcn_s_getreg((3 << 11) | 20) & 0xFu; }
#define XB_SPIN(cond, bar) do { unsigned _sp = 0; while (cond) { __builtin_amdgcn_s_sleep(1); \
    if ((++_sp & 255u) == 0u) { if (xb_ld(&(bar)[XB_TMO])) break; if (_sp > XB_SPIN_CAP) { atomicAdd(&(bar)[XB_TMO], 1u); break; } } } } while (0)

struct XcdBarrier {
    unsigned* bar; unsigned x;
    volatile LAS unsigned* st;
};

__device__ __forceinline__ XcdBarrier xcd_barrier_post(unsigned* bar, volatile LAS unsigned* st) {
    XcdBarrier b; b.bar = bar; b.x = xb_xcc_id(); b.st = st;
    if (threadIdx.x == 0) (void)xb_add(&bar[XB_XCNT(b.x)], 1u);
    return b;
}
__device__ __forceinline__ void xcd_barrier_complete(unsigned* bar, unsigned x, unsigned& nloc, unsigned& nx) {
    const unsigned G = gridDim.x * gridDim.y * gridDim.z;
    unsigned sum, cnt, mine, sp = 0u;
    for (;;) {
        sum = 0u; cnt = 0u; mine = 0u;
#pragma unroll
        for (unsigned j = 0; j < 16; ++j) { const unsigned c = xb_ld(&bar[XB_XCNT(j)]); sum += c; cnt += (c > 0u) ? 1u : 0u; mine = (j == x) ? c : mine; }
        if (sum == G) break;
        __builtin_amdgcn_s_sleep(1);
        if ((++sp & 255u) == 0u) { if (xb_ld(&bar[XB_TMO])) break; if (sp > XB_SPIN_CAP) { atomicAdd(&bar[XB_TMO], 1u); break; } }
    }
    nloc = mine > 0u ? mine : 1u; nx = cnt > 0u ? cnt : 1u;
}

__device__ __forceinline__ void xcd_barrier(const XcdBarrier& b) {
    asm volatile("s_waitcnt vmcnt(0)" ::: "memory");
    __syncthreads();
    if (threadIdx.x == 0) {
        unsigned* bar = b.bar;
        __builtin_amdgcn_s_waitcnt(0);
        unsigned nloc = b.st[0], nx = b.st[1];
        if (nloc == 0u) { xcd_barrier_complete(bar, b.x, nloc, nx); b.st[0] = nloc; b.st[1] = nx; }
        const unsigned old = xb_add(&bar[XB_XSUB(b.x)], 1u);
        const unsigned gen = old / nloc;
        if (old + 1u == (gen + 1u) * nloc) {
            __builtin_amdgcn_fence(__ATOMIC_RELEASE, "agent");
            asm volatile("s_waitcnt vmcnt(0)" ::: "memory");
            const unsigned og = xb_add(&bar[XB_TOP], 1u);
            const unsigned tg = og / nx;
            if (og + 1u == (tg + 1u) * nx) xb_add(&bar[XB_TOPGEN], 1u);
            else XB_SPIN(xb_ld(&bar[XB_TOPGEN]) == tg, bar);
            __builtin_amdgcn_fence(__ATOMIC_ACQUIRE, "agent");
            xb_add(&bar[XB_XGEN(b.x)], 1u);
            asm volatile("s_waitcnt vmcnt(0)" ::: "memory");
        } else {
            XB_SPIN(xb_ld(&bar[XB_XGEN(b.x)]) == gen, bar);
            __builtin_amdgcn_fence(__ATOMIC_ACQUIRE, "agent");
            asm volatile("s_waitcnt vmcnt(0)" ::: "memory");
        }
    }
    __syncthreads();
}

namespace att {
constexpr int DQ = 192, NW = 8, QBLK = 32, KVBLK = 64;
constexpr float SCALE = 0.07216878364870322f;
constexpr float THR = 8.f;
constexpr int LDQ = 192, LDKK = 192, LDV = 2048, LDO = 1024;
constexpr int SHM_V = KVBLK * 128 * 2, SHM_K = KVBLK * DQ * 2, SHM_ATTN = 2 * SHM_V + 2 * SHM_K + NW * 64 * 4;
#define KSWZ(row, colB) ((row) * 384 + ((colB) ^ (((row) & 7) << 4)))
#define SBAR() __builtin_amdgcn_sched_barrier(0)
__device__ __forceinline__ int crow(int r, int hi) { return (r & 3) + 8 * (r >> 2) + 4 * hi; }
__device__ __forceinline__ unsigned cvtpk(float lo, float hi) { unsigned r; asm volatile("v_cvt_pk_bf16_f32 %0, %1, %2" : "=v"(r) : "v"(lo), "v"(hi)); return r; }

__device__ __forceinline__ void partialSM(f32x16& p0, f32x16& p1, float& m_reg, float& mn, float& alpha) {
  constexpr float C = SCALE * 1.4426950408889634f;
  float pmax = p0[0];
#pragma unroll
  for (int r = 1; r < 16; ++r) pmax = fmaxf(pmax, p0[r]);
#pragma unroll
  for (int r = 0; r < 16; ++r) pmax = fmaxf(pmax, p1[r]);
  { auto rr = __builtin_amdgcn_permlane32_swap(__float_as_uint(pmax), __float_as_uint(pmax), false, false);
    pmax = fmaxf(__uint_as_float(rr[0]), __uint_as_float(rr[1])); }
  if (__builtin_expect(__all(pmax - m_reg <= THR / SCALE), 1)) { mn = m_reg; alpha = 1.f; }
  else { mn = fmaxf(m_reg, pmax); alpha = __builtin_amdgcn_exp2f((m_reg - mn) * C); m_reg = mn; }
  float mnC = -mn * C;
#pragma unroll
  for (int r = 0; r < 16; ++r) p0[r] = fmaf(p0[r], C, mnC);
#pragma unroll
  for (int r = 0; r < 16; ++r) p1[r] = fmaf(p1[r], C, mnC);
#pragma unroll
  for (int r = 0; r < 16; ++r) p0[r] = __builtin_amdgcn_exp2f(p0[r]);
}
__device__ __forceinline__ void finishSM(f32x16& p0, f32x16& p1, float alpha, float& l_reg, bf16x8& pa0, bf16x8& pa1, bf16x8& pa2, bf16x8& pa3) {
#pragma unroll
  for (int r = 0; r < 16; ++r) p1[r] = __builtin_amdgcn_exp2f(p1[r]);
  float ps = 0;
#pragma unroll
  for (int r = 0; r < 16; ++r) ps += p0[r];
#pragma unroll
  for (int r = 0; r < 16; ++r) ps += p1[r];
  { auto rr = __builtin_amdgcn_permlane32_swap(__float_as_uint(ps), __float_as_uint(ps), false, false);
    ps = __uint_as_float(rr[0]) + __uint_as_float(rr[1]); }
  l_reg = l_reg * alpha + ps;
#define PK4(P, BASE, OUT) do { unsigned a0 = cvtpk(P[BASE + 0], P[BASE + 1]), a1 = cvtpk(P[BASE + 2], P[BASE + 3]);   \
    unsigned b0 = cvtpk(P[BASE + 4], P[BASE + 5]), b1 = cvtpk(P[BASE + 6], P[BASE + 7]);                              \
    auto r0 = __builtin_amdgcn_permlane32_swap(a0, b0, false, false); auto r1 = __builtin_amdgcn_permlane32_swap(a1, b1, false, false); \
    u32x4 w = {r0[0], r1[0], r0[1], r1[1]}; OUT = *reinterpret_cast<bf16x8*>(&w); } while (0)
  PK4(p0, 0, pa0); PK4(p0, 8, pa1); PK4(p1, 0, pa2); PK4(p1, 8, pa3);
#undef PK4
}
__device__ __forceinline__ void qkt(f32x16& p0, f32x16& p1, const char* Ks, const bf16x8* qr, int r32, int hi, bool dead) {
  p0 = f32x16{}; p1 = f32x16{};
#pragma unroll
  for (int d0 = 0; d0 < 12; ++d0) { const int cb = (d0 * 16 + hi * 8) * 2;
    bf16x8 b0 = *reinterpret_cast<const bf16x8*>(Ks + KSWZ(r32, cb));
    bf16x8 b1 = *reinterpret_cast<const bf16x8*>(Ks + KSWZ(32 + r32, cb));
    p0 = __builtin_amdgcn_mfma_f32_32x32x16_bf16(b0, qr[d0], p0, 0, 0, 0);
    p1 = __builtin_amdgcn_mfma_f32_32x32x16_bf16(b1, qr[d0], p1, 0, 0, 0);
    if ((d0 & 3) == 3) SBAR(); }
  if (dead) {
#pragma unroll
    for (int r = 0; r < 16; ++r) { p0[r] = -1e30f; p1[r] = -1e30f; } }
}
__device__ __forceinline__ int v_st(int k, int c) { const int kk = (k & ~0xC) | ((k & 4) << 1) | ((k & 8) >> 1); return ((kk >> 3) * 4 + (c >> 5)) * 512 + ((kk & 7) * 32 + (c & 31)) * 2; }
__device__ __forceinline__ int v_rd_base(int lane) { return ((lane & 3) << 3) | (((lane >> 2) & 3) << 6) | (((lane >> 4) & 1) << 5) | (((lane >> 5) & 1) << 8); }
constexpr int v_rd_off(int d0, int ks, int half) { return d0 * 512 + ks * 4096 + half * 2048; }
template <int OFF> __device__ __forceinline__ s16x4 tr_read(int vb) {
  s16x4 r; asm volatile("ds_read_b64_tr_b16 %0, %1 offset:%2" : "=&v"(r) : "v"(vb), "i"(OFF) : "memory"); return r;
}
template <int D0> __device__ __forceinline__ void pv_one(f32x16& od, int vb, bf16x8 pa0, bf16x8 pa1, bf16x8 pa2, bf16x8 pa3) {
  const s16x4 l0 = tr_read<v_rd_off(D0, 0, 0)>(vb), h0 = tr_read<v_rd_off(D0, 0, 1)>(vb), l1 = tr_read<v_rd_off(D0, 1, 0)>(vb), h1 = tr_read<v_rd_off(D0, 1, 1)>(vb);
  const s16x4 l2 = tr_read<v_rd_off(D0, 2, 0)>(vb), h2 = tr_read<v_rd_off(D0, 2, 1)>(vb), l3 = tr_read<v_rd_off(D0, 3, 0)>(vb), h3 = tr_read<v_rd_off(D0, 3, 1)>(vb);
  asm volatile("s_waitcnt lgkmcnt(0)" ::: "memory"); SBAR();
#define PK(L, H) (bf16x8){L[0], L[1], L[2], L[3], H[0], H[1], H[2], H[3]}
  od = __builtin_amdgcn_mfma_f32_32x32x16_bf16(pa0, PK(l0, h0), od, 0, 0, 0);
  od = __builtin_amdgcn_mfma_f32_32x32x16_bf16(pa1, PK(l1, h1), od, 0, 0, 0);
  od = __builtin_amdgcn_mfma_f32_32x32x16_bf16(pa2, PK(l2, h2), od, 0, 0, 0);
  od = __builtin_amdgcn_mfma_f32_32x32x16_bf16(pa3, PK(l3, h3), od, 0, 0, 0);
#undef PK
}
__device__ __forceinline__ void pv_d0(f32x16* o, int vb, bf16x8 pa0, bf16x8 pa1, bf16x8 pa2, bf16x8 pa3) {
  pv_one<0>(o[0], vb, pa0, pa1, pa2, pa3); pv_one<1>(o[1], vb, pa0, pa1, pa2, pa3); pv_one<2>(o[2], vb, pa0, pa1, pa2, pa3); pv_one<3>(o[3], vb, pa0, pa1, pa2, pa3);
}

__device__ __forceinline__ void attn_unit(const bf16* __restrict__ Qb, const bf16* __restrict__ Kh, const bf16* __restrict__ Vh, bf16* __restrict__ Ob, int qb, char* lds) {
  int tid_ = threadIdx.x; asm volatile("" : "+v"(tid_));
  const int tid = tid_, wid = tid >> 6, lane = tid & 63, r32 = lane & 31, hi = lane >> 5;
  char* V_lds = lds; char* K_lds = lds + 2 * SHM_V;
  float* ws = (float*)(lds + 2 * SHM_V + 2 * SHM_K) + wid * 64; float* li_l = ws; float* al_l = ws + 32;
  float m_reg = -1e30f, l_reg = 0; f32x16 o[4] = {}; bf16x8 qr[12];
  const bf16* Qw = Qb + (long)(wid * QBLK + r32) * LDQ + hi * 8;
#pragma unroll
  for (int d0 = 0; d0 < 12; ++d0) qr[d0] = *reinterpret_cast<const bf16x8*>(Qw + d0 * 16);
  const int sr = tid >> 4, sc = (tid & 15) * 8, vst0 = v_st(sr, sc), vst1 = v_st(32 + sr, sc);
  const int kr = tid >> 3, kc = 128 + (tid & 7) * 8;
  const int vb0 = (int)(uintptr_t)V_lds + v_rd_base(lane);
  const int NT = 4 * qb + 4, NTw = 4 * qb + 1 + (wid >> 1);
  bf16x8 vs0, vs1, ks0, ks1, ks2;
#define SLOAD(k0) do { vs0 = *reinterpret_cast<const bf16x8*>(&Vh[(long)((k0) + sr) * LDV + sc]); vs1 = *reinterpret_cast<const bf16x8*>(&Vh[(long)((k0) + 32 + sr) * LDV + sc]); \
    ks0 = *reinterpret_cast<const bf16x8*>(&Kh[(long)((k0) + sr) * LDKK + sc]); ks1 = *reinterpret_cast<const bf16x8*>(&Kh[(long)((k0) + 32 + sr) * LDKK + sc]); \
    ks2 = *reinterpret_cast<const bf16x8*>(&Kh[(long)((k0) + kr) * LDKK + kc]); } while (0)
#define SWRITE(b) do { *(bf16x8*)(V_lds + (b) * SHM_V + vst0) = vs0; *(bf16x8*)(V_lds + (b) * SHM_V + vst1) = vs1; \
    *(bf16x8*)(K_lds + (b) * SHM_K + KSWZ(sr, sc * 2)) = ks0; *(bf16x8*)(K_lds + (b) * SHM_K + KSWZ(32 + sr, sc * 2)) = ks1; \
    *(bf16x8*)(K_lds + (b) * SHM_K + KSWZ(kr, kc * 2)) = ks2; } while (0)
#define SWAIT() asm volatile("s_waitcnt vmcnt(0)" ::: "memory")
#define RESC(a) do { if (__any((a) < 1.f)) { if (hi == 0) al_l[r32] = (a); asm volatile("s_waitcnt lgkmcnt(0)" ::: "memory"); \
    _Pragma("unroll") for (int d = 0; d < 4; ++d) _Pragma("unroll") for (int r = 0; r < 16; ++r) o[d][r] *= al_l[crow(r, hi)]; } } while (0)
  f32x16 pA0, pA1; float mnA, alA; bf16x8 pa0, pa1, pa2, pa3;
  SLOAD(0); SWAIT(); SWRITE(0); __syncthreads();
#pragma unroll 1
  for (int j = 0; j < NT; ++j) {
    const int cur = j & 1;
    if (j + 1 < NT) SLOAD((j + 1) * KVBLK);
    SBAR(); qkt(pA0, pA1, K_lds + cur * SHM_K, qr, r32, hi, j >= NTw);
    partialSM(pA0, pA1, m_reg, mnA, alA);
    RESC(alA);
    finishSM(pA0, pA1, alA, l_reg, pa0, pa1, pa2, pa3); SBAR();
    pv_d0(o, vb0 + cur * SHM_V, pa0, pa1, pa2, pa3);
    if (j + 1 < NT) { SWAIT(); SWRITE(cur ^ 1); }
    __syncthreads();
  }
  if (hi == 0) li_l[r32] = l_reg; asm volatile("s_waitcnt lgkmcnt(0)" ::: "memory");
  float rli[16];
#pragma unroll
  for (int r = 0; r < 16; ++r) rli[r] = __builtin_amdgcn_rcpf(li_l[crow(r, hi)]);
  bf16* Ow = Ob + (long)(wid * QBLK) * LDO;
#pragma unroll
  for (int r = 0; r < 16; ++r) { const int orow = crow(r, hi);
#pragma unroll
    for (int d0 = 0; d0 < 4; ++d0) Ow[(long)orow * LDO + d0 * 32 + r32] = (bf16)f2bf(o[d0][r] * rli[r]); }
  __syncthreads();
#undef SLOAD
#undef SWRITE
#undef SWAIT
#undef RESC
}
#undef SBAR
}

struct Args {
    const float* in[27]; float* out; unsigned char* ws; float freq[32];
};
struct Frame {
    LAS unsigned char* lds;
    volatile LAS unsigned* MISC;
    gu32* ctl;
    int tid, lane, wave, vcu, G;
};
enum { I_X = 0, I_P, I_POS, I_NORM_MIX, I_W_IN, I_G_QLAT, I_G_KVLAT, I_W_UQ, I_W_UKV, I_G_QHEAD, I_G_KHEAD, I_W_CONV, I_G_OUT_ATTN, I_G_OUT_CONV, I_W_OUT,
       I_NORM_MOE, I_W_GROUP, I_B_GROUP, I_W_ROUTER, I_B_ROUTER, I_W1, I_W3, I_W2, I_NORM_PLE, I_W_PLE, I_W_PLE_GATE, I_B_PLE_GATE };

template <int MODE> __device__ __forceinline__ int rowmap(int n) {
    if (MODE == 0) return n;
    if (MODE == 1) return (n / 192) * 256 + (n % 192);
    if (MODE == 2) return ((n >> 4) << 5) + (n & 15);
    return ((n >> 4) << 5) + 16 + (n & 15);
}
template <int MODE> __device__ __forceinline__ void transpose_item(const float* W, int K, int N, bf16* WT, LAS float* scr, int item, int lane) {
    const int nblk = N / 32, kb = item / nblk, nb = item % nblk, k0 = 64 * kb, n0 = 32 * nb;
    float tmp[32];
#pragma unroll
    for (int i = 0; i < 32; ++i) { const int kk = 2 * i + (lane >> 5); tmp[i] = __builtin_nontemporal_load(W + (size_t)(k0 + kk) * N + n0 + (lane & 31)); }
#pragma unroll
    for (int i = 0; i < 32; ++i) { const int kk = 2 * i + (lane >> 5); scr[kk * 33 + (lane & 31)] = tmp[i]; }
    LDS_WAIT(); asm volatile("" ::: "memory");
    const int c = lane & 7;
#pragma unroll
    for (int j = 0; j < 4; ++j) { const int n = (lane >> 3) + 8 * j; const LAS float* s = scr + (8 * c) * 33 + n;
        u32x4 o; o.x = pk2(s[0 * 33], s[1 * 33]); o.y = pk2(s[2 * 33], s[3 * 33]); o.z = pk2(s[4 * 33], s[5 * 33]); o.w = pk2(s[6 * 33], s[7 * 33]);
        __builtin_nontemporal_store(o, (u32x4*)(WT + (size_t)rowmap<MODE>(n0 + n) * K + k0 + 8 * c)); }
    LDS_WAIT(); asm volatile("" ::: "memory");
}
__device__ __forceinline__ void rms_row_to_bf16(const float* xrow, const float* g, bf16* orow, int lane) {
    const f32x4* xr = (const f32x4*)xrow + lane; const f32x4* gr = (const f32x4*)g + lane;
    f32x4 v[8]; float s = 0.f;
#pragma unroll
    for (int j = 0; j < 8; ++j) { v[j] = xr[64 * j]; s += (v[j].x * v[j].x + v[j].y * v[j].y) + (v[j].z * v[j].z + v[j].w * v[j].w); }
    const float rs = 1.0f / sqrtf(wave_sum(s) * (1.f / DM) + EPS);
    u32x2* o8 = (u32x2*)orow + lane;
#pragma unroll
    for (int j = 0; j < 8; ++j) { const f32x4 gg = gr[64 * j]; u32x2 w; w.x = pk2(v[j].x * rs * gg.x, v[j].y * rs * gg.y); w.y = pk2(v[j].z * rs * gg.z, v[j].w * rs * gg.w); o8[64 * j] = w; }
}

__device__ __forceinline__ void p0_prologue(Frame& F, const Args& a) {
    unsigned char* ws = a.ws;
    LAS float* scr = (LAS float*)(F.lds + RING_OFF + F.wave * 16384);
    const int gw = F.vcu * NWAVES + F.wave, NGW = F.G * NWAVES, lane = F.lane;
    bf16* WinT = (bf16*)(ws + WS_WIN); bf16* WuqT = (bf16*)(ws + WS_WUQ); bf16* WukvT = (bf16*)(ws + WS_WUKV); bf16* WpleT = (bf16*)(ws + WS_WPLE);
    bf16* WoutT = (bf16*)(ws + WS_WOUT); bf16* WpgT = (bf16*)(ws + WS_WPG); bf16* W13T = (bf16*)(ws + WS_W13); bf16* W2T = (bf16*)(ws + WS_W2);
    constexpr int I_IN = (DM / 64) * (DIN / 32), I_UQ = (QR / 64) * (NH * QKH / 32), I_UKV = (KVR / 64) * (DM / 32), I_OUT = (DM / 64) * (DM / 32), I_PG = I_OUT, I_PL = (PLE / 64) * (DM / 32);
    constexpr int I_E1 = (DM / 64) * (DE / 32), I_E2 = (DE / 64) * (DM / 32);
    constexpr int I_SMALL = I_IN + I_UQ + I_UKV + I_OUT + I_PG + I_PL;
    constexpr int NITEMS = I_SMALL;
    for (int it = gw; it < NITEMS; it += NGW) {
        int r = it;
        if (r < I_IN) { transpose_item<0>(a.in[I_W_IN], DM, DIN, WinT, scr, r, lane); continue; } r -= I_IN;
        if (r < I_UQ) { transpose_item<1>(a.in[I_W_UQ], QR, NH * QKH, WuqT, scr, r, lane); continue; } r -= I_UQ;
        if (r < I_UKV) { transpose_item<0>(a.in[I_W_UKV], KVR, DM, WukvT, scr, r, lane); continue; } r -= I_UKV;
        if (r < I_OUT) { transpose_item<0>(a.in[I_W_OUT], DM, DM, WoutT, scr, r, lane); continue; } r -= I_OUT;
        if (r < I_PG) { transpose_item<0>(a.in[I_W_PLE_GATE], DM, DM, WpgT, scr, r, lane); continue; } r -= I_PG;
        if (r < I_PL) { transpose_item<0>(a.in[I_W_PLE], PLE, DM, WpleT, scr, r, lane); continue; } r -= I_PL;
    }
    {
        const int gt = (F.vcu * NWAVES + F.wave) * 64 + lane, NGT = NGW * 64;
        const u32x4 z = {0u, 0u, 0u, 0u};
        for (int i = gt; i < (DINP - DIN) * DM / 8; i += NGT) *(u32x4*)(WinT + (size_t)DIN * DM + (size_t)i * 8) = z;
        for (int i = gt; i < NH * 64 * QR / 8; i += NGT) { const int h = i / (64 * QR / 8), rr = i % (64 * QR / 8); *(u32x4*)(WuqT + ((size_t)h * 256 + 192) * QR + (size_t)rr * 8) = z; }
        const float* p = a.in[I_P]; bf16* Pb = (bf16*)(ws + WS_PB);
        for (int i = gt; i < T_TOK * PLE / 8; i += NGT) { const f32x4 x0 = *(const f32x4*)(p + (size_t)i * 8), x1 = *(const f32x4*)(p + (size_t)i * 8 + 4);
            u32x4 w; w.x = pk2(x0.x, x0.y); w.y = pk2(x0.z, x0.w); w.z = pk2(x1.x, x1.y); w.w = pk2(x1.z, x1.w); *(u32x4*)(Pb + (size_t)i * 8) = w; }
        const int* pos = (const int*)a.in[I_POS]; float* CS = (float*)(ws + WS_CS);
        for (int i = gt; i < T_TOK * 32; i += NGT) { const int t = i >> 5, fi = i & 31;
            const float ang = (float)pos[t] * a.freq[fi];
            const double rev = (double)ang * 0.15915494309189535; const float fr = (float)(rev - rint(rev));
            CS[t * 64 + fi] = __builtin_amdgcn_cosf(fr); CS[t * 64 + 32 + fi] = __builtin_amdgcn_sinf(fr); }
    }
    bf16* XN = (bf16*)(ws + WS_R1);
    for (int m = gw; m < T_TOK; m += NGW) rms_row_to_bf16(a.in[I_X] + (size_t)m * DM, a.in[I_NORM_MIX], XN + (size_t)m * DM, lane);
}

__device__ __forceinline__ void moe_convert_dyn(Frame& F, const Args& a) {
    unsigned char* ws = a.ws;
    LAS float* scr = (LAS float*)(F.lds + RING_OFF + F.wave * 16384);
    bf16* W13T = (bf16*)(ws + WS_W13); bf16* W2T = (bf16*)(ws + WS_W2);
    constexpr int I_E1 = (DM / 64) * (DE / 32), I_E2 = (DE / 64) * (DM / 32), PER_E = 2 * I_E1 + I_E2, NIT = NE * PER_E;
    unsigned* ctr = (unsigned*)(ws + WS_CTL) + CW_QCONV;
    volatile LAS unsigned* slot = F.MISC + 12;
    const int lane = F.lane;
    for (;;) {
        if (F.tid == 0) slot[0] = atomicAdd(ctr, 64u);
        __syncthreads();
        const int base = (int)slot[0];
        __syncthreads();
        if (base >= NIT) break;
#pragma unroll 1
        for (int q = 0; q < 8; ++q) {
            const int it = base + F.wave * 8 + q; if (it >= NIT) break;
            const int e = it / PER_E; int r = it - e * PER_E;
            if (r < I_E1) transpose_item<2>(a.in[I_W1] + (size_t)e * DM * DE, DM, DE, W13T + (size_t)e * 1024 * DM, scr, r, lane);
            else if (r < 2 * I_E1) transpose_item<3>(a.in[I_W3] + (size_t)e * DM * DE, DM, DE, W13T + (size_t)e * 1024 * DM, scr, r - I_E1, lane);
            else transpose_item<0>(a.in[I_W2] + (size_t)e * DE * DM, DE, DM, W2T + (size_t)e * DM * DE, scr, r - 2 * I_E1, lane);
        }
    }
}

__device__ __forceinline__ void p2a_rows(Frame& F, const Args& a) {
    unsigned char* ws = a.ws;
    const bf16* PROJ = (const bf16*)(ws + WS_R2); bf16* QLN = (bf16*)(ws + WS_QLN); bf16* KVLN = (bf16*)(ws + WS_KVLN); bf16* YMIX = (bf16*)(ws + WS_R4);
    const float* gq = a.in[I_G_QLAT]; const float* gkv = a.in[I_G_KVLAT]; const float* wconv = a.in[I_W_CONV]; const float* gc = a.in[I_G_OUT_CONV];
    const int gw = F.vcu * NWAVES + F.wave, NGW = F.G * NWAVES, lane = F.lane;
    for (int t = gw; t < T_TOK; t += NGW) {
        const bf16* pr = PROJ + (size_t)t * DINP; const int s = t & (SEQ - 1);
        {
            const u32x4 w = *(const u32x4*)(pr + OFF_QLAT + lane * 8);
            float v[8] = {bflo(w.x), bfhi(w.x), bflo(w.y), bfhi(w.y), bflo(w.z), bfhi(w.z), bflo(w.w), bfhi(w.w)}; float ss = 0.f;
#pragma unroll
            for (int i = 0; i < 8; ++i) ss += v[i] * v[i];
            const float rs = 1.0f / sqrtf(wave_sum(ss) * (1.f / QR) + EPS);
            const f32x4 g0 = *(const f32x4*)(gq + lane * 8), g1 = *(const f32x4*)(gq + lane * 8 + 4);
            u32x4 o; o.x = pk2(v[0] * rs * g0.x, v[1] * rs * g0.y); o.y = pk2(v[2] * rs * g0.z, v[3] * rs * g0.w); o.z = pk2(v[4] * rs * g1.x, v[5] * rs * g1.y); o.w = pk2(v[6] * rs * g1.z, v[7] * rs * g1.w);
            *(u32x4*)(QLN + (size_t)t * QR + lane * 8) = o;
        }
        {
            const u32x2 w = *(const u32x2*)(pr + OFF_KVLAT + lane * 4);
            float v[4] = {bflo(w.x), bfhi(w.x), bflo(w.y), bfhi(w.y)}; float ss = (v[0] * v[0] + v[1] * v[1]) + (v[2] * v[2] + v[3] * v[3]);
            const float rs = 1.0f / sqrtf(wave_sum(ss) * (1.f / KVR) + EPS);
            const f32x4 g0 = *(const f32x4*)(gkv + lane * 4);
            u32x2 o; o.x = pk2(v[0] * rs * g0.x, v[1] * rs * g0.y); o.y = pk2(v[2] * rs * g0.z, v[3] * rs * g0.w);
            *(u32x2*)(KVLN + (size_t)t * KVR + lane * 4) = o;
        }
        {
            float y[16]; float ss = 0.f;
#pragma unroll
            for (int j = 0; j < 2; ++j) { const int ch = lane * 8 + 512 * j;
                float u0[8], u1[8], u2[8], bb[8];
                { const u32x4 c = *(const u32x4*)(pr + OFF_C + ch), h = *(const u32x4*)(pr + OFF_H + ch), b = *(const u32x4*)(pr + OFF_B + ch);
                  u2[0] = bflo(c.x) * bflo(h.x); u2[1] = bfhi(c.x) * bfhi(h.x); u2[2] = bflo(c.y) * bflo(h.y); u2[3] = bfhi(c.y) * bfhi(h.y);
                  u2[4] = bflo(c.z) * bflo(h.z); u2[5] = bfhi(c.z) * bfhi(h.z); u2[6] = bflo(c.w) * bflo(h.w); u2[7] = bfhi(c.w) * bfhi(h.w);
                  bb[0] = bflo(b.x); bb[1] = bfhi(b.x); bb[2] = bflo(b.y); bb[3] = bfhi(b.y); bb[4] = bflo(b.z); bb[5] = bfhi(b.z); bb[6] = bflo(b.w); bb[7] = bfhi(b.w); }
                if (s >= 1) { const bf16* p1 = pr - DINP; const u32x4 c = *(const u32x4*)(p1 + OFF_C + ch), h = *(const u32x4*)(p1 + OFF_H + ch);
                  u1[0] = bflo(c.x) * bflo(h.x); u1[1] = bfhi(c.x) * bfhi(h.x); u1[2] = bflo(c.y) * bflo(h.y); u1[3] = bfhi(c.y) * bfhi(h.y);
                  u1[4] = bflo(c.z) * bflo(h.z); u1[5] = bfhi(c.z) * bfhi(h.z); u1[6] = bflo(c.w) * bflo(h.w); u1[7] = bfhi(c.w) * bfhi(h.w); }
                else {
#pragma unroll
                  for (int i = 0; i < 8; ++i) u1[i] = 0.f; }
                if (s >= 2) { const bf16* p2 = pr - 2 * DINP; const u32x4 c = *(const u32x4*)(p2 + OFF_C + ch), h = *(const u32x4*)(p2 + OFF_H + ch);
                  u0[0] = bflo(c.x) * bflo(h.x); u0[1] = bfhi(c.x) * bfhi(h.x); u0[2] = bflo(c.y) * bflo(h.y); u0[3] = bfhi(c.y) * bfhi(h.y);
                  u0[4] = bflo(c.z) * bflo(h.z); u0[5] = bfhi(c.z) * bfhi(h.z); u0[6] = bflo(c.w) * bflo(h.w); u0[7] = bfhi(c.w) * bfhi(h.w); }
                else {
#pragma unroll
                  for (int i = 0; i < 8; ++i) u0[i] = 0.f; }
                float w0[8], w1[8], w2[8];
                { const f32x4 a0 = *(const f32x4*)(wconv + ch), a1 = *(const f32x4*)(wconv + ch + 4); w0[0] = a0.x; w0[1] = a0.y; w0[2] = a0.z; w0[3] = a0.w; w0[4] = a1.x; w0[5] = a1.y; w0[6] = a1.z; w0[7] = a1.w; }
                { const f32x4 a0 = *(const f32x4*)(wconv + DC + ch), a1 = *(const f32x4*)(wconv + DC + ch + 4); w1[0] = a0.x; w1[1] = a0.y; w1[2] = a0.z; w1[3] = a0.w; w1[4] = a1.x; w1[5] = a1.y; w1[6] = a1.z; w1[7] = a1.w; }
                { const f32x4 a0 = *(const f32x4*)(wconv + 2 * DC + ch), a1 = *(const f32x4*)(wconv + 2 * DC + ch + 4); w2[0] = a0.x; w2[1] = a0.y; w2[2] = a0.z; w2[3] = a0.w; w2[4] = a1.x; w2[5] = a1.y; w2[6] = a1.z; w2[7] = a1.w; }
#pragma unroll
                for (int i = 0; i < 8; ++i) { const float v = bb[i] * (u0[i] * w0[i] + u1[i] * w1[i] + u2[i] * w2[i]); y[j * 8 + i] = v; ss += v * v; }
            }
            const float rs = 1.0f / sqrtf(wave_sum(ss) * (1.f / DC) + EPS);
#pragma unroll
            for (int j = 0; j < 2; ++j) { const int ch = lane * 8 + 512 * j; const f32x4 g0 = *(const f32x4*)(gc + ch), g1 = *(const f32x4*)(gc + ch + 4);
                u32x4 o; o.x = pk2(y[j * 8 + 0] * rs * g0.x, y[j * 8 + 1] * rs * g0.y); o.y = pk2(y[j * 8 + 2] * rs * g0.z, y[j * 8 + 3] * rs * g0.w);
                o.z = pk2(y[j * 8 + 4] * rs * g1.x, y[j * 8 + 5] * rs * g1.y); o.w = pk2(y[j * 8 + 6] * rs * g1.z, y[j * 8 + 7] * rs * g1.w);
                *(u32x4*)(YMIX + (size_t)t * DM + DC + ch) = o; }
        }
    }
}

__device__ __forceinline__ void p2c_qk(Frame& F, const Args& a) {
    unsigned char* ws = a.ws;
    const bf16* QRAW = (const bf16*)(ws + WS_R1); const bf16* KVRAW = (const bf16*)(ws + WS_KVRAW); const bf16* PROJ = (const bf16*)(ws + WS_R2); const float* CS = (const float*)(ws + WS_CS);
    bf16* Q = (bf16*)(ws + WS_Q); bf16* K = (bf16*)(ws + WS_K);
    const float* gqh = a.in[I_G_QHEAD]; const float* gkh = a.in[I_G_KHEAD];
    const int gw = F.vcu * NWAVES + F.wave, NGW = F.G * NWAVES, lane = F.lane;
    const float gq0 = gqh[lane], gq1 = gqh[64 + lane], gq2 = gqh[128 + lane], gk0 = gkh[lane], gk1 = gkh[64 + lane], gk2 = gkh[128 + lane];
    for (int t = gw; t < T_TOK; t += NGW) {
        const int b = t >> 12, s = t & (SEQ - 1), fi = lane & 31;
        const float cs = CS[t * 64 + fi], sn = CS[t * 64 + 32 + fi];
        const float krope = bf2f(PROJ[(size_t)t * DINP + OFF_KROPE + lane]); const float ssr = wave_sum(krope * krope);
#pragma unroll 1
        for (int h = 0; h < NH; ++h) {
            {
                const bf16* q = QRAW + (size_t)t * DM + h * 256;
                const float x0 = bf2f(q[lane]), x1 = bf2f(q[64 + lane]), x2 = bf2f(q[128 + lane]);
                const float rs = 1.0f / sqrtf(wave_sum(x0 * x0 + x1 * x1 + x2 * x2) * (1.f / QKH) + EPS);
                const float y0 = x0 * rs * gq0, y1 = x1 * rs * gq1, y2 = x2 * rs * gq2;
                const float yp = __shfl_xor(y2, 32);
                const float r = (lane < 32) ? (y2 * cs - yp * sn) : (y2 * cs + yp * sn);
                bf16* o = Q + ((size_t)(b * NH + h) * SEQ + s) * QKH;
                o[lane] = (bf16)f2bf(y0); o[64 + lane] = (bf16)f2bf(y1); o[128 + lane] = (bf16)f2bf(r);
            }
            {
                const bf16* k = KVRAW + (size_t)t * DM + h * 256;
                const float x0 = bf2f(k[lane]), x1 = bf2f(k[64 + lane]);
                const float rs = 1.0f / sqrtf((wave_sum(x0 * x0 + x1 * x1) + ssr) * (1.f / QKH) + EPS);
                const float y0 = x0 * rs * gk0, y1 = x1 * rs * gk1, y2 = krope * rs * gk2;
                const float yp = __shfl_xor(y2, 32);
                const float r = (lane < 32) ? (y2 * cs - yp * sn) : (y2 * cs + yp * sn);
                bf16* o = K + ((size_t)(b * NH + h) * SEQ + s) * QKH;
                o[lane] = (bf16)f2bf(y0); o[64 + lane] = (bf16)f2bf(y1); o[128 + lane] = (bf16)f2bf(r);
            }
        }
    }
}

__device__ __forceinline__ void p3b_rows(Frame& F, const Args& a) {
    unsigned char* ws = a.ws;
    const bf16* O = (const bf16*)(ws + WS_R2); bf16* YMIX = (bf16*)(ws + WS_R4); const float* ga = a.in[I_G_OUT_ATTN];
    const int gw = F.vcu * NWAVES + F.wave, NGW = F.G * NWAVES, lane = F.lane;
    for (int t = gw; t < T_TOK; t += NGW) {
        float v[16]; float ss = 0.f;
#pragma unroll
        for (int j = 0; j < 2; ++j) { const u32x4 w = *(const u32x4*)(O + (size_t)t * 1024 + lane * 8 + 512 * j);
            v[j * 8 + 0] = bflo(w.x); v[j * 8 + 1] = bfhi(w.x); v[j * 8 + 2] = bflo(w.y); v[j * 8 + 3] = bfhi(w.y); v[j * 8 + 4] = bflo(w.z); v[j * 8 + 5] = bfhi(w.z); v[j * 8 + 6] = bflo(w.w); v[j * 8 + 7] = bfhi(w.w); }
#pragma unroll
        for (int i = 0; i < 16; ++i) ss += v[i] * v[i];
        const float rs = 1.0f / sqrtf(wave_sum(ss) * (1.f / 1024) + EPS);
#pragma unroll
        for (int j = 0; j < 2; ++j) { const int ch = lane * 8 + 512 * j; const f32x4 g0 = *(const f32x4*)(ga + ch), g1 = *(const f32x4*)(ga + ch + 4);
            u32x4 o; o.x = pk2(v[j * 8 + 0] * rs * g0.x, v[j * 8 + 1] * rs * g0.y); o.y = pk2(v[j * 8 + 2] * rs * g0.z, v[j * 8 + 3] * rs * g0.w);
            o.z = pk2(v[j * 8 + 4] * rs * g1.x, v[j * 8 + 5] * rs * g1.y); o.w = pk2(v[j * 8 + 6] * rs * g1.z, v[j * 8 + 7] * rs * g1.w);
            *(u32x4*)(YMIX + (size_t)t * DM + ch) = o; }
    }
}

typedef float f32x16r __attribute__((ext_vector_type(16)));
__device__ __forceinline__ void p5_route(Frame& F, const Args& a, bool commit) {
    unsigned char* ws = a.ws;
    const float* H1 = a.out; const float* gm = a.in[I_NORM_MOE]; float* RS = (float*)(ws + WS_RS);
    const float* wg = a.in[I_W_GROUP]; const float* bg = a.in[I_B_GROUP]; const float* wr = a.in[I_W_ROUTER]; const float* br = a.in[I_B_ROUTER];
    int* LIST = (int*)(ws + WS_LIST); float* WTOP = (float*)(ws + WS_WTOP); unsigned* cnt = (unsigned*)(ws + WS_CTL) + CW_CNT;
    LAS float* red = (LAS float*)(F.lds + RING_OFF);
    LAS float* redg = red + 8 * 32 * 33;
    LAS float* redss = redg + 8 * 32 * 4;
    LAS float* fin = redss + 8 * 32;
    const int lane = F.lane, w = F.wave, i = lane & 31, kk = lane >> 5;
    for (int c = F.vcu; c < T_TOK / 32; c += F.G) {
        const int t0 = c * 32;
        const float* hrow = H1 + (size_t)(t0 + i) * DM + 256 * w + 4 * kk;
        f32x16r acc = {0.f, 0.f, 0.f, 0.f, 0.f, 0.f, 0.f, 0.f, 0.f, 0.f, 0.f, 0.f, 0.f, 0.f, 0.f, 0.f};
        float ss = 0.f; f32x4 g4 = {0.f, 0.f, 0.f, 0.f};
#pragma unroll 4
        for (int s = 0; s < 32; ++s) {
            const int kb = 256 * w + 8 * s + 4 * kk;
            const f32x4 h = *(const f32x4*)(hrow + 8 * s); const f32x4 gk = *(const f32x4*)(gm + kb);
            ss += (h.x * h.x + h.y * h.y) + (h.z * h.z + h.w * h.w);
            const f32x4 av = h * gk;
#pragma unroll
            for (int q = 0; q < 4; ++q) { const float bq = wr[(size_t)(kb + q) * NE + i]; const f32x4 wgk = *(const f32x4*)(wg + (size_t)(kb + q) * 4);
                acc = __builtin_amdgcn_mfma_f32_32x32x2f32(av[q], bq, acc, 0, 0, 0); g4 += wgk * av[q]; }
        }
        ss += __shfl_xor(ss, 32);
#pragma unroll
        for (int q = 0; q < 4; ++q) g4[q] += __shfl_xor(g4[q], 32);
#pragma unroll
        for (int r = 0; r < 16; ++r) red[(w * 32 + (r & 3) + 8 * (r >> 2) + 4 * kk) * 33 + i] = acc[r];
        if (kk == 0) { redss[w * 32 + i] = ss;
#pragma unroll
            for (int q = 0; q < 4; ++q) redg[(w * 32 + i) * 4 + q] = g4[q]; }
        __syncthreads();
        {
            const int ti = F.tid >> 4, jq = F.tid & 15; float s0 = 0.f, s1 = 0.f, s2 = 0.f;
#pragma unroll
            for (int ww = 0; ww < 8; ++ww) { s0 += red[(ww * 32 + ti) * 33 + jq]; s1 += red[(ww * 32 + ti) * 33 + jq + 16];
                if (jq < 4) s2 += redg[(ww * 32 + ti) * 4 + jq]; else if (jq == 4) s2 += redss[ww * 32 + ti]; }
            fin[ti * 40 + jq] = s0; fin[ti * 40 + jq + 16] = s1; if (jq < 5) fin[ti * 40 + 32 + jq] = s2;
        }
        __syncthreads();
        if (F.tid < 32) {
            const int t = t0 + F.tid; const LAS float* f = fin + F.tid * 40;
            const float rs = 1.0f / sqrtf(f[36] * (1.f / DM) + EPS);
            float gl[4];
#pragma unroll
            for (int g = 0; g < 4; ++g) gl[g] = f[32 + g] * rs + bg[g];
            int gsel = 0; float gmax = gl[0];
#pragma unroll
            for (int g = 1; g < 4; ++g) if (gl[g] > gmax) { gmax = gl[g]; gsel = g; }
            float gsum = 0.f;
#pragma unroll
            for (int g = 0; g < 4; ++g) gsum += __expf(gl[g] - gmax);
            const float pg = 1.f / gsum;
            float el[8];
#pragma unroll
            for (int j = 0; j < 8; ++j) el[j] = f[gsel * 8 + j] * rs + br[gsel * 8 + j];
            int i0 = 0; float v0 = el[0];
#pragma unroll
            for (int j = 1; j < 8; ++j) if (el[j] > v0) { v0 = el[j]; i0 = j; }
            int i1 = -1; float v1 = -INFINITY;
#pragma unroll
            for (int j = 0; j < 8; ++j) if (j != i0 && el[j] > v1) { v1 = el[j]; i1 = j; }
            const float ex = __expf(v1 - v0); const float w0 = pg / (1.f + ex), w1 = pg * ex / (1.f + ex);
            if (commit) {
                RS[t] = rs;
                const int e0 = gsel * 8 + i0, e1 = gsel * 8 + i1;
                const unsigned p0 = atomicAdd(cnt + e0, 1u); LIST[e0 * T_TOK + p0] = 2 * t; WTOP[2 * t] = w0;
                const unsigned p1 = atomicAdd(cnt + e1, 1u); LIST[e1 * T_TOK + p1] = 2 * t + 1; WTOP[2 * t + 1] = w1;
            }
        }
        __syncthreads();
    }
}

__device__ __forceinline__ void p6_gather(Frame& F, const Args& a) {
    unsigned char* ws = a.ws;
    const float* H1 = a.out; const float* gm = a.in[I_NORM_MOE]; const float* RS = (const float*)(ws + WS_RS);
    bf16* XS = (bf16*)(ws + WS_XS); const int* LIST = (const int*)(ws + WS_LIST); int* ROWTOK = (int*)(ws + WS_ROWTOK);
    unsigned* cnt = (unsigned*)(ws + WS_CTL) + CW_CNT;
    volatile LAS int* toff = (volatile LAS int*)(F.MISC + 16);
    volatile LAS int* ecnt = (volatile LAS int*)(F.MISC + 56);
    if (F.tid == 0) { int acc = 0; for (int e = 0; e < NE; ++e) { const int c = (int)__hip_atomic_load(cnt + e, RLX_AGENT); toff[e] = acc; ecnt[e] = c; acc += (c + 255) >> 8; } toff[NE] = acc; }
    __syncthreads();
    const int ntile = toff[NE];
    const int gw = F.vcu * NWAVES + F.wave, NGW = F.G * NWAVES, lane = F.lane;
    f32x4 gg[8];
#pragma unroll
    for (int j = 0; j < 8; ++j) gg[j] = ((const f32x4*)gm)[lane + 64 * j];
    for (int r = gw; r < ntile * 256; r += NGW) {
        const int tile = r >> 8; int e = 0;
#pragma unroll 1
        for (int j = 1; j < NE; ++j) if (toff[j] <= tile) e = j;
        const int pos = r - toff[e] * 256;
        u32x2* dst = (u32x2*)(XS + (size_t)r * DM) + lane;
        if (pos < ecnt[e]) { const int tk = LIST[e * T_TOK + pos]; const int tok = tk >> 1; const f32x4* src = (const f32x4*)(H1 + (size_t)tok * DM) + lane; const float rs = RS[tok];
#pragma unroll
            for (int j = 0; j < 8; ++j) { const f32x4 v = src[64 * j]; u32x2 o; o.x = pk2(v.x * rs * gg[j].x, v.y * rs * gg[j].y); o.y = pk2(v.z * rs * gg[j].z, v.w * rs * gg[j].w); dst[64 * j] = o; }
            if (lane == 0) ROWTOK[r] = tk; }
        else { const u32x2 z = {0u, 0u};
#pragma unroll
            for (int j = 0; j < 8; ++j) dst[64 * j] = z;
            if (lane == 0) ROWTOK[r] = -1; }
    }
}

__device__ __forceinline__ void p9_rows(Frame& F, const Args& a) {
    unsigned char* ws = a.ws;
    float* H = a.out; const bf16* Y = (const bf16*)(ws + WS_R2); bf16* HN = (bf16*)(ws + WS_R1); const float* gp = a.in[I_NORM_PLE];
    const int gw = F.vcu * NWAVES + F.wave, NGW = F.G * NWAVES, lane = F.lane;
    for (int t = gw; t < T_TOK; t += NGW) {
        f32x4* xr = (f32x4*)(H + (size_t)t * DM) + lane; const f32x4* gr = (const f32x4*)gp + lane;
        const u32x2* y0 = (const u32x2*)(Y + (size_t)(2 * t) * DM) + lane; const u32x2* y1 = (const u32x2*)(Y + (size_t)(2 * t + 1) * DM) + lane;
        f32x4 v[8]; float s = 0.f;
#pragma unroll
        for (int j = 0; j < 8; ++j) { v[j] = xr[64 * j]; const u32x2 a0 = y0[64 * j], a1 = y1[64 * j];
            v[j].x += bflo(a0.x) + bflo(a1.x); v[j].y += bfhi(a0.x) + bfhi(a1.x); v[j].z += bflo(a0.y) + bflo(a1.y); v[j].w += bfhi(a0.y) + bfhi(a1.y);
            xr[64 * j] = v[j]; s += (v[j].x * v[j].x + v[j].y * v[j].y) + (v[j].z * v[j].z + v[j].w * v[j].w); }
        const float rs = 1.0f / sqrtf(wave_sum(s) * (1.f / DM) + EPS);
        u32x2* o8 = (u32x2*)(HN + (size_t)t * DM) + lane;
#pragma unroll
        for (int j = 0; j < 8; ++j) { const f32x4 gg = gr[64 * j]; u32x2 w; w.x = pk2(v[j].x * rs * gg.x, v[j].y * rs * gg.y); w.y = pk2(v[j].z * rs * gg.z, v[j].w * rs * gg.w); o8[64 * j] = w; }
    }
}

#ifndef PHASE_MASK
#define PHASE_MASK 0xFFFF
#endif
#define PHASE_ON(k) (((PHASE_MASK) >> (k)) & 1)
#ifndef DUP_MASK
#define DUP_MASK 0
#endif
#define NREP(k) (PHASE_ON(k) ? 1 + (((DUP_MASK) >> (k)) & 1) : 0)

template <class Epi, class Sched>
__device__ __forceinline__ void run_gemm(LAS unsigned char* lds, const pg8::Gemm g, const Sched& S, const Epi& E) {
#if USE_PG8
    pg8::gemm_phase<Epi, Sched, false, true>(lds, g, S, E);
#else
    pg8::gemm_simple<Epi, Sched>(g, S, E);
    __syncthreads();
#endif
}

__global__ void __launch_bounds__(NWAVES * 64, 2) mega_fwd(Args args) {
    extern __shared__ __attribute__((aligned(16))) unsigned char lds[];
    Frame F;
    F.lds = (LAS unsigned char*)lds;
    F.MISC = (volatile LAS unsigned*)(F.lds + MISC_OFF);
    F.tid = threadIdx.x; F.lane = F.tid & 63; F.wave = __builtin_amdgcn_readfirstlane(F.tid >> 6);
    F.G = gridDim.x; { const int bx = blockIdx.x; F.vcu = (F.G % 8 == 0) ? (bx % 8) * (F.G / 8) + bx / 8 : bx; }
    unsigned char* ws = args.ws;
    F.ctl = (gu32*)(ws + WS_CTL);
    for (int u = F.tid; u < (LDS_BYTES - LDSCTL_OFF) / 4; u += NWAVES * 64) ((LAS unsigned*)(F.lds + LDSCTL_OFF))[u] = 0u;
    __syncthreads();
    XcdBarrier bar = xcd_barrier_post((unsigned*)(F.ctl + CW_BAR), F.MISC + 8);
#define GRID_BAR() xcd_barrier(bar)
    const int G = F.G, bx = (int)blockIdx.x;

    for (int rep = 0; rep < NREP(0); ++rep) {
    p0_prologue(F, args);
    GRID_BAR();

    }
    for (int rep = 0; rep < NREP(1); ++rep) {
    {
        pg8::Gemm g{(const bf16*)(ws + WS_R1), (const bf16*)(ws + WS_WIN), T_TOK, DINP, DM}; pg8::StaticOrder S; S.init(T_TOK, DINP, G, bx);
        EpiBf16Plain E{(bf16*)(ws + WS_R2), DINP};
        run_gemm(F.lds + RING_OFF, g, S, E);
    }
    {
        pg8::Gemm g{(const bf16*)(ws + WS_PB), (const bf16*)(ws + WS_WPLE), T_TOK, DM, PLE}; pg8::StaticOrder S; S.init(T_TOK, DM, G, bx);
        EpiBf16Plain E{(bf16*)(ws + WS_PE), DM};
        run_gemm(F.lds + RING_OFF, g, S, E);
    }
    GRID_BAR();

    }
    for (int rep = 0; rep < NREP(2); ++rep) {
    p2a_rows(F, args);
    GRID_BAR();

    }
    for (int rep = 0; rep < NREP(3); ++rep) {
    {
        pg8::Gemm g{(const bf16*)(ws + WS_QLN), (const bf16*)(ws + WS_WUQ), T_TOK, DM, QR}; pg8::StaticOrder S; S.init(T_TOK, DM, G, bx);
        EpiBf16Plain E{(bf16*)(ws + WS_R1), DM};
        run_gemm(F.lds + RING_OFF, g, S, E);
    }
    {
        pg8::Gemm g{(const bf16*)(ws + WS_KVLN), (const bf16*)(ws + WS_WUKV), T_TOK, DM, KVR}; pg8::StaticOrder S; S.init(T_TOK, DM, G, bx);
        EpiBf16Plain E{(bf16*)(ws + WS_KVRAW), DM};
        run_gemm(F.lds + RING_OFF, g, S, E);
    }
    GRID_BAR();

    }
    for (int rep = 0; rep < NREP(4); ++rep) {
    p2c_qk(F, args);
    GRID_BAR();

    }
    for (int rep = 0; rep < NREP(5); ++rep) {
    {
        const bf16* Q = (const bf16*)(ws + WS_Q); const bf16* K = (const bf16*)(ws + WS_K); const bf16* KVRAW = (const bf16*)(ws + WS_KVRAW); bf16* O = (bf16*)(ws + WS_R2);
        for (int u = F.vcu; u < 256; u += G) {
            const int bh = u >> 4, qb = u & 15, b = bh >> 3, h = bh & 7;
            att::attn_unit(Q + ((size_t)bh * SEQ + qb * 256) * QKH, K + (size_t)bh * SEQ * QKH, KVRAW + (size_t)b * SEQ * DM + h * 256 + 128,
                           O + ((size_t)b * SEQ + qb * 256) * 1024 + h * 128, qb, (char*)lds + RING_OFF);
        }
        if (rep == 0) moe_convert_dyn(F, args);
    }
    GRID_BAR();

    }
    for (int rep = 0; rep < NREP(6); ++rep) {
    p3b_rows(F, args);
    GRID_BAR();

    }
    for (int rep = 0; rep < NREP(7); ++rep) {
    {
        pg8::Gemm g{(const bf16*)(ws + WS_R4), (const bf16*)(ws + WS_WOUT), T_TOK, DM, DM}; pg8::StaticOrder S; S.init(T_TOK, DM, G, bx);
        EpiResF32 E{args.in[I_X], args.out, DM};
        run_gemm(F.lds + RING_OFF, g, S, E);
    }
    GRID_BAR();

    }
    for (int rep = 0; rep < NREP(8); ++rep) {
    p5_route(F, args, rep == 0);
    GRID_BAR();

    }
    for (int rep = 0; rep < NREP(9); ++rep) {
    p6_gather(F, args);
    GRID_BAR();

    }
    for (int rep = 0; rep < NREP(10); ++rep) {
    {
        pg8::Gemm g{(const bf16*)(ws + WS_XS), (const bf16*)(ws + WS_W13), MAXROWS, 1024, DM};
        pg8::MoeOrder S{(const volatile LAS int*)(F.MISC + 16), 4, G, bx};
        EpiSwiGLU E{(bf16*)(ws + WS_R4)};
        run_gemm(F.lds + RING_OFF, g, S, E);
    }
    GRID_BAR();

    }
    for (int rep = 0; rep < NREP(11); ++rep) {
    {
        pg8::Gemm g{(const bf16*)(ws + WS_R4), (const bf16*)(ws + WS_W2), MAXROWS, DM, DE};
        pg8::MoeOrder S{(const volatile LAS int*)(F.MISC + 16), 8, G, bx};
        EpiMoeOut E{(bf16*)(ws + WS_R2), (const int*)(ws + WS_ROWTOK), (const float*)(ws + WS_WTOP)};
        run_gemm(F.lds + RING_OFF, g, S, E);
    }
    GRID_BAR();

    }
    for (int rep = 0; rep < NREP(12); ++rep) {
    p9_rows(F, args);
    GRID_BAR();

    }
    for (int rep = 0; rep < NREP(13); ++rep) {
    {
        pg8::Gemm g{(const bf16*)(ws + WS_R1), (const bf16*)(ws + WS_WPG), T_TOK, DM, DM}; pg8::StaticOrder S; S.init(T_TOK, DM, G, bx);
        EpiGate E{args.out, (const bf16*)(ws + WS_PE), args.in[I_B_PLE_GATE]};
        run_gemm(F.lds + RING_OFF, g, S, E);
    }
}
    }

extern "C" void kernel_launch(void* const* d_in, const int* in_sizes, int n_in, void* d_out, int out_size, void* d_ws, size_t ws_size, hipStream_t stream) {
    static int grid = 0;
    if (grid == 0) {
        if (n_in != 27 || out_size != T_TOK * DM || ws_size < WS_END) { fprintf(stderr, "kernel_launch: unexpected shapes: n_in %d out %d ws %zu (need %zu)\n", n_in, out_size, ws_size, (size_t)WS_END); grid = -1; return; }
        int dev = 0, cus = 0, per_cu = 0;
        if (hipGetDevice(&dev) != hipSuccess || hipDeviceGetAttribute(&cus, hipDeviceAttributeMultiprocessorCount, dev) != hipSuccess) { grid = -1; return; }
        if (hipFuncSetAttribute((const void*)mega_fwd, hipFuncAttributeMaxDynamicSharedMemorySize, LDS_BYTES) != hipSuccess) { fprintf(stderr, "kernel_launch: hipFuncSetAttribute failed\n"); grid = -1; return; }
        if (hipOccupancyMaxActiveBlocksPerMultiprocessor(&per_cu, (const void*)mega_fwd, NWAVES * 64, LDS_BYTES) != hipSuccess || per_cu < 1)
            fprintf(stderr, "kernel_launch: note: occupancy query reports %d\n", per_cu);
        (void)hipGetLastError();
        grid = cus;
    }
    if (grid < 0) return;
    if (hipMemsetAsync((char*)d_ws + WS_CTL, 0, CTL_ZERO_BYTES, stream) != hipSuccess) { fprintf(stderr, "kernel_launch: memset failed\n"); return; }
    Args a{};
    for (int i = 0; i < 27; ++i) a.in[i] = (const float*)d_in[i];
    a.out = (float*)d_out; a.ws = (unsigned char*)d_ws;
    for (int i = 0; i < 32; ++i) a.freq[i] = powf(10000.0f, -(float)(2 * i) / 64.0f);
    hipLaunchKernelGGL(mega_fwd, dim3(grid), dim3(NWAVES * 64), LDS_BYTES, stream, a);
    const hipError_t le = hipPeekAtLastError();
    if (le != hipSuccess) fprintf(stderr, "kernel_launch: launch failed: %s\n", hipGetErrorName(le));
}
```

```cpp
#include <hip/hip_runtime.h>
#include <cstdio>
#include <cstdint>
#include <cmath>

#ifndef USE_PG8
#define USE_PG8 1
#endif

#define GAS __attribute__((address_space(1)))
#define LAS __attribute__((address_space(3)))
typedef unsigned short bf16;
typedef short bf16x8 __attribute__((ext_vector_type(8)));
typedef short s16x4 __attribute__((ext_vector_type(4)));
typedef float f32x4 __attribute__((ext_vector_type(4)));
typedef float f32x16 __attribute__((ext_vector_type(16)));
typedef unsigned u32x4 __attribute__((ext_vector_type(4)));
typedef unsigned u32x2 __attribute__((ext_vector_type(2)));
typedef GAS unsigned gu32;

constexpr int T_TOK = 8192, SEQ = 4096, DM = 2048, DIN = 3904, DINP = 4096;
constexpr int QR = 512, KVR = 256, ROPE = 64, DC = 1024, NH = 8, QKH = 192, VH = 128;
constexpr int NE = 32, DE = 512, PLE = 256;
constexpr int OFF_QLAT = 0, OFF_KVLAT = 512, OFF_KROPE = 768, OFF_B = 832, OFF_C = 1856, OFF_H = 2880;
constexpr float EPS = 1e-6f;
constexpr int MAXROWS = 24576;

constexpr size_t MiB = 1u << 20;
constexpr size_t WS_CTL = 0, CTL_ZERO_BYTES = 1 * MiB;
constexpr size_t WS_CS = 1 * MiB;
constexpr size_t WS_WTOP = 3 * MiB;
constexpr size_t WS_ROWTOK = 3 * MiB + 256 * 1024;
constexpr size_t WS_RS = 3 * MiB + 512 * 1024;
constexpr size_t WS_LIST = 4 * MiB;
constexpr size_t WS_WIN = 5 * MiB;
constexpr size_t WS_WUQ = 21 * MiB;
constexpr size_t WS_WUKV = 23 * MiB;
constexpr size_t WS_WPLE = 24 * MiB;
constexpr size_t WS_WOUT = 25 * MiB;
constexpr size_t WS_WPG = 33 * MiB;
constexpr size_t WS_W13 = 41 * MiB;
constexpr size_t WS_W2 = 169 * MiB;
constexpr size_t WS_R1 = 233 * MiB;
constexpr size_t WS_R2 = 265 * MiB;
constexpr size_t WS_PE = 329 * MiB;
constexpr size_t WS_R4 = 361 * MiB;
constexpr size_t WS_KVRAW = 393 * MiB;
constexpr size_t WS_Q = 425 * MiB;
constexpr size_t WS_K = 449 * MiB;
constexpr size_t WS_QLN = 473 * MiB;
constexpr size_t WS_KVLN = 481 * MiB;
constexpr size_t WS_PB = 485 * MiB;
constexpr size_t WS_XS = 393 * MiB;
constexpr size_t WS_END = 489 * MiB;
constexpr int CW_TMO = 0, CW_CODE = 1, CW_BAR = 4096, CW_CNT = 16384, CW_QCONV = 16512;

constexpr int RING_OFF = 0, RING_BYTES = 131072;
constexpr int LDSCTL_OFF = RING_BYTES, MISC_OFF = LDSCTL_OFF + 320;
constexpr int LDS_BYTES = 147456;
constexpr int NWAVES = 8;

#define LDS_WAIT() asm volatile("s_waitcnt lgkmcnt(0)" ::: "memory")
#define VM_WAIT() asm volatile("s_waitcnt vmcnt(0)" ::: "memory")
#define RLX_AGENT __ATOMIC_RELAXED, __HIP_MEMORY_SCOPE_AGENT

__device__ __forceinline__ unsigned f2bf(float f) { unsigned u = __builtin_bit_cast(unsigned, f); return (u + 0x7fffu + ((u >> 16) & 1u)) >> 16; }
__device__ __forceinline__ unsigned pk2(float lo, float hi) { return f2bf(lo) | (f2bf(hi) << 16); }
__device__ __forceinline__ float bf2f(unsigned short b) { return __builtin_bit_cast(float, (unsigned)b << 16); }
__device__ __forceinline__ float bflo(unsigned w) { return __builtin_bit_cast(float, w << 16); }
__device__ __forceinline__ float bfhi(unsigned w) { return __builtin_bit_cast(float, w & 0xffff0000u); }
__device__ __forceinline__ float wave_sum(float v) {
#pragma unroll
    for (int o = 1; o < 64; o <<= 1) v += __shfl_xor(v, o);
    return v;
}

namespace pg8 {
#define PG8_LAS __attribute__((address_space(3)))
typedef unsigned short bf16_t;
constexpr int BM = 256, BK = 64, HALF = 128, HTB = HALF * BK * 2, STAGE_BYTES = 8 * HTB, NXCD = 8, WGM = 8;
__host__ __device__ __forceinline__ int lds_byte(int r, int c) { const int st = (r >> 4) * 2 + (c >> 5), rr = r & 15, cc = c & 31, ob = rr * 64 + cc * 2; return st * 1024 + (ob ^ (((ob >> 9) & 1) << 5)); }
__host__ __device__ __forceinline__ void stage_rc(int b, int& R, int& C) { const int st = b / 1024, sb = b % 1024, swz = sb ^ (((sb >> 9) & 1) << 5); R = (st >> 1) * 16 + swz / 64; C = (st & 1) * 32 + (swz % 64) / 2; }
__host__ __device__ __forceinline__ int perm32(int rho) { const int n = rho >> 4, i = rho & 15; return 8 * (i >> 2) + 4 * n + (i & 3); }

struct Unit { int pm, pn, pb; };
struct Gemm { const bf16_t* A; const bf16_t* Bt; int M, N, K; };

struct StaticOrder {
    int nM, nN, nwg, G, c;
    __host__ __device__ void init(int M, int N, int G_, int c_) { nM = M / BM; nN = N / BM; nwg = nM * nN; G = G_; c = c_; }
    __host__ __device__ bool next(int i, Unit& u) const {
        const long L = (long)i * G + c; if (L >= nwg) return false;
        int wgid = (int)L; { const int q = nwg / NXCD, r = nwg % NXCD, xcd = wgid % NXCD, off = wgid / NXCD; wgid = (xcd < r ? xcd * (q + 1) : r * (q + 1) + (xcd - r) * q) + off; }
        const int nig = WGM * nN, gid = wgid / nig, fm = gid * WGM, gsz = (nM - fm) < WGM ? (nM - fm) : WGM;
        u.pm = fm + ((wgid % nig) % gsz); u.pn = (wgid % nig) / gsz; u.pb = u.pn; return true;
    }
    __device__ __forceinline__ void a_ready(const Unit&) const {}
    __device__ __forceinline__ void done(const Unit&) const {}
};
struct MoeOrder {
    const volatile LAS int* toff; int NPN, G, c;
    __device__ __forceinline__ bool next(int i, Unit& u) const {
        const int L = i * G + c; const int nt = toff[NE];
        if (L >= nt * NPN) return false;
        const int tile = L / NPN, pn = L - tile * NPN; int e = 0;
#pragma unroll 1
        for (int j = 1; j < NE; ++j) if (toff[j] <= tile) e = j;
        u.pm = tile; u.pn = pn; u.pb = e * NPN + pn; return true;
    }
    __device__ __forceinline__ void a_ready(const Unit&) const {}
    __device__ __forceinline__ void done(const Unit&) const {}
};

template <class Epi, class Sched>
__device__ __forceinline__ void gemm_simple(const Gemm g, const Sched& S, const Epi& E) {
    const int tid = threadIdx.x, wid = __builtin_amdgcn_readfirstlane(tid >> 6), lane = tid & 63, wr = wid >> 2, wc = wid & 3, fr = lane & 15, fq = lane >> 4;
    const int K = g.K;
    Unit u;
    for (int i = 0; S.next(i, u); ++i) {
        f32x4 acc[2][2][4][2];
#pragma unroll
        for (int a = 0; a < 2; ++a)
#pragma unroll
            for (int b = 0; b < 2; ++b)
#pragma unroll
                for (int m = 0; m < 4; ++m)
#pragma unroll
                    for (int n = 0; n < 2; ++n) acc[a][b][m][n] = (f32x4){0.f, 0.f, 0.f, 0.f};
        const bf16_t* Ab = g.A + (size_t)(u.pm * BM + wr * 64 + fr) * K + fq * 8;
        const bf16_t* Bb = g.Bt + (size_t)(u.pb * BM + wc * 32 + fr) * K + fq * 8;
#pragma unroll 1
        for (int k0 = 0; k0 < K; k0 += 32) {
            bf16x8 a[2][4], b[2][2];
#pragma unroll
            for (int ai = 0; ai < 2; ++ai)
#pragma unroll
                for (int m = 0; m < 4; ++m) a[ai][m] = *(const bf16x8*)(Ab + (size_t)(ai * HALF + m * 16) * K + k0);
#pragma unroll
            for (int bj = 0; bj < 2; ++bj)
#pragma unroll
                for (int n = 0; n < 2; ++n) b[bj][n] = *(const bf16x8*)(Bb + (size_t)(bj * HALF + n * 16) * K + k0);
#pragma unroll
            for (int ai = 0; ai < 2; ++ai)
#pragma unroll
                for (int bj = 0; bj < 2; ++bj)
#pragma unroll
                    for (int m = 0; m < 4; ++m)
#pragma unroll
                        for (int n = 0; n < 2; ++n) acc[ai][bj][m][n] = __builtin_amdgcn_mfma_f32_16x16x32_bf16(b[bj][n], a[ai][m], acc[ai][bj][m][n], 0, 0, 0);
        }
        E(acc, u, wr, wc, fr, fq);
    }
}
template <class Epi, class Sched, bool ALIGN_EPI = false, bool SP2 = false>
__device__ __forceinline__ void gemm_phase(PG8_LAS unsigned char* lds, const Gemm g, const Sched& S, const Epi& E) {
    int tid_ = threadIdx.x; asm volatile("" : "+v"(tid_));
    const int tid = tid_, wid = __builtin_amdgcn_readfirstlane(tid >> 6), lane = tid & 63, wr = wid >> 2, wc = wid & 3, fr = lane & 15, fq = lane >> 4;
    const int K = g.K, nt = K / BK;
    unsigned voffA[2], voffB[2];
#pragma unroll
    for (int i = 0; i < 2; ++i) { int R, C; stage_rc(tid * 16 + i * 8192, R, C); const int Rb = Epi::PERM ? ((R & ~31) + perm32(R & 31)) : R;
        voffA[i] = (unsigned)(R * K + C) * 2u; voffB[i] = (unsigned)(Rb * K + C) * 2u; }
    const size_t kstep = (size_t)(BK * 2);
    const size_t hstep = (size_t)HALF * K * 2;
    const size_t tstep = 2 * hstep;
    const unsigned ldsw = (unsigned)wid * 1024u;
    const int aoff = lds_byte(wr * 64 + fr, fq * 8), boff = lds_byte(wc * 32 + fr, fq * 8);
#define PG8_SA(b, h) (((b) * 2 + (h)) * HTB)
#define PG8_SB(b, h) ((4 + (b) * 2 + (h)) * HTB)
#define PG8_STAGE(bufoff, gbase, voff) do { _Pragma("unroll") for (int _i = 0; _i < 2; ++_i) \
        __builtin_amdgcn_global_load_lds((const unsigned*)((const char*)(gbase) + (voff)[_i]), (PG8_LAS unsigned*)(lds + (bufoff) + ldsw + _i * 8192), 16, 0, 0); } while (0)
#define PG8_LDA(dst, b, h) do { _Pragma("unroll") for (int m = 0; m < 4; ++m) _Pragma("unroll") for (int k = 0; k < 2; ++k) dst[m][k] = *(const PG8_LAS bf16x8*)(lds + PG8_SA(b, h) + aoff + m * 2048 + k * 1024); } while (0)
#define PG8_LDB(dst, b, h) do { _Pragma("unroll") for (int n = 0; n < 2; ++n) _Pragma("unroll") for (int k = 0; k < 2; ++k) dst[n][k] = *(const PG8_LAS bf16x8*)(lds + PG8_SB(b, h) + boff + n * 2048 + k * 1024); } while (0)
#define PG8_MMA(ai, bj, At, Bt) do { __builtin_amdgcn_s_setprio(1); _Pragma("unroll") for (int m = 0; m < 4; ++m) _Pragma("unroll") for (int n = 0; n < 2; ++n) _Pragma("unroll") for (int k = 0; k < 2; ++k) \
        acc[ai][bj][m][n] = __builtin_amdgcn_mfma_f32_16x16x32_bf16(Bt[n][k], At[m][k], acc[ai][bj][m][n], 0, 0, 0); __builtin_amdgcn_s_setprio(0); } while (0)
#define PG8_WAIT_V(n) asm volatile("s_waitcnt vmcnt(" #n ")" ::: "memory")
#define PG8_WAIT_L(n) asm volatile("s_waitcnt lgkmcnt(" #n ")" ::: "memory")
#define PG8_BAR __builtin_amdgcn_s_barrier()
#define PG8_SCHED __builtin_amdgcn_sched_barrier(0)
    Unit cur, nxt; int ui = 0;
    if (!S.next(0, cur)) return;
    f32x4 acc[2][2][4][2];
#pragma unroll
    for (int a = 0; a < 2; ++a)
#pragma unroll
        for (int b = 0; b < 2; ++b)
#pragma unroll
            for (int m = 0; m < 4; ++m)
#pragma unroll
                for (int n = 0; n < 2; ++n) acc[a][b][m][n] = (f32x4){0.f, 0.f, 0.f, 0.f};
    bf16x8 At[4][2], B0[2][2], B1[2][2];
    const char* cA = (const char*)g.A + (size_t)cur.pm * tstep; const char* cB = (const char*)g.Bt + (size_t)cur.pb * tstep;
    S.a_ready(cur);
    if constexpr (SP2) {
        PG8_STAGE(PG8_SB(0, 0), cB, voffB); PG8_STAGE(PG8_SB(0, 1), cB + hstep, voffB); PG8_STAGE(PG8_SA(0, 0), cA, voffA); PG8_STAGE(PG8_SA(0, 1), cA + hstep, voffA);
        if (wr == 1) PG8_BAR;
        PG8_WAIT_V(2); PG8_BAR;
        PG8_STAGE(PG8_SB(1, 0), cB + kstep, voffB); PG8_STAGE(PG8_SA(1, 0), cA + kstep, voffA); PG8_STAGE(PG8_SB(1, 1), cB + hstep + kstep, voffB);
        PG8_WAIT_V(6); PG8_BAR;
    } else {
        PG8_STAGE(PG8_SB(0, 0), cB, voffB); PG8_STAGE(PG8_SA(0, 0), cA, voffA); PG8_STAGE(PG8_SB(0, 1), cB + hstep, voffB); PG8_STAGE(PG8_SA(0, 1), cA + hstep, voffA);
        if (wr == 1) PG8_BAR;
        PG8_WAIT_V(4); PG8_BAR;
        PG8_STAGE(PG8_SB(1, 0), cB + kstep, voffB); PG8_STAGE(PG8_SA(1, 0), cA + kstep, voffA); PG8_STAGE(PG8_SB(1, 1), cB + hstep + kstep, voffB);
        PG8_WAIT_V(6); PG8_BAR;
    }
    for (;;) {
        const bool has_next = S.next(ui + 1, nxt);
        const char* nA = has_next ? (const char*)g.A + (size_t)nxt.pm * tstep : cA; const char* nB = has_next ? (const char*)g.Bt + (size_t)nxt.pb * tstep : cB;
        for (int t = 0; t < nt; t += 2) {
            const bool last = (t == nt - 2);
            const char* a1 = cA + (size_t)(t + 1) * kstep;
            const char* a2 = last ? nA : cA + (size_t)(t + 2) * kstep; const char* b2 = last ? nB : cB + (size_t)(t + 2) * kstep;
            const char* a3 = a2 + kstep; const char* b3 = b2 + kstep;
            if (last && has_next) S.a_ready(nxt);
            if constexpr (SP2) {
            PG8_LDB(B0, 0, 0); PG8_LDB(B1, 0, 1); PG8_SCHED; PG8_LDA(At, 0, 0); PG8_STAGE(PG8_SA(1, 1), a1 + hstep, voffA);
            PG8_WAIT_V(8); PG8_WAIT_L(0); PG8_BAR; PG8_MMA(0, 0, At, B0); PG8_MMA(0, 1, At, B1); PG8_BAR; PG8_SCHED;
            PG8_LDA(At, 0, 1); PG8_STAGE(PG8_SB(0, 0), b2, voffB); PG8_STAGE(PG8_SB(0, 1), b2 + hstep, voffB); PG8_STAGE(PG8_SA(0, 0), a2, voffA);
            PG8_WAIT_V(8); PG8_WAIT_L(0); PG8_BAR; PG8_MMA(1, 0, At, B0); PG8_MMA(1, 1, At, B1); PG8_BAR; PG8_SCHED;
            PG8_LDB(B0, 1, 0); PG8_LDB(B1, 1, 1); PG8_SCHED; PG8_LDA(At, 1, 0); PG8_STAGE(PG8_SA(0, 1), a2 + hstep, voffA);
            PG8_WAIT_V(8); PG8_WAIT_L(0); PG8_BAR; PG8_MMA(0, 0, At, B0); PG8_MMA(0, 1, At, B1); PG8_BAR; PG8_SCHED;
            PG8_LDA(At, 1, 1); PG8_STAGE(PG8_SB(1, 0), b3, voffB); PG8_STAGE(PG8_SB(1, 1), b3 + hstep, voffB); PG8_STAGE(PG8_SA(1, 0), a3, voffA);
            PG8_WAIT_V(8); PG8_WAIT_L(0); PG8_BAR; PG8_MMA(1, 0, At, B0); PG8_MMA(1, 1, At, B1); PG8_BAR; PG8_SCHED;
            } else {
            PG8_LDB(B0, 0, 0); PG8_SCHED; PG8_LDA(At, 0, 0); PG8_STAGE(PG8_SA(1, 1), a1 + hstep, voffA);
            PG8_WAIT_L(8); PG8_BAR; PG8_WAIT_L(0); PG8_MMA(0, 0, At, B0); PG8_BAR; PG8_SCHED;
            PG8_LDB(B1, 0, 1); PG8_STAGE(PG8_SB(0, 0), b2, voffB);
            PG8_BAR; PG8_WAIT_L(0); PG8_MMA(0, 1, At, B1); PG8_BAR;
            PG8_LDA(At, 0, 1); PG8_STAGE(PG8_SA(0, 0), a2, voffA);
            PG8_BAR; PG8_WAIT_L(0); PG8_MMA(1, 0, At, B0); PG8_BAR; PG8_SCHED;
            PG8_STAGE(PG8_SB(0, 1), b2 + hstep, voffB);
            PG8_WAIT_V(6); PG8_BAR; PG8_MMA(1, 1, At, B1); PG8_BAR;
            PG8_LDB(B0, 1, 0); PG8_SCHED; PG8_LDA(At, 1, 0); PG8_STAGE(PG8_SA(0, 1), a2 + hstep, voffA);
            PG8_WAIT_L(8); PG8_BAR; PG8_WAIT_L(0); PG8_MMA(0, 0, At, B0); PG8_BAR; PG8_SCHED;
            PG8_LDB(B1, 1, 1); PG8_STAGE(PG8_SB(1, 0), b3, voffB);
            PG8_BAR; PG8_WAIT_L(0); PG8_MMA(0, 1, At, B1); PG8_BAR;
            PG8_LDA(At, 1, 1); PG8_STAGE(PG8_SA(1, 0), a3, voffA);
            PG8_BAR; PG8_WAIT_L(0); PG8_MMA(1, 0, At, B0); PG8_BAR; PG8_SCHED;
            PG8_STAGE(PG8_SB(1, 1), b3 + hstep, voffB);
            PG8_WAIT_V(6); PG8_BAR; PG8_MMA(1, 1, At, B1); PG8_BAR;
            }
        }
        if constexpr (ALIGN_EPI) { if (wr == 0) PG8_BAR; }
        if constexpr (!Epi::AFTER_DRAIN) { E(acc, cur, wr, wc, fr, fq); S.done(cur); }
        if (!has_next) break;
#pragma unroll
        for (int a = 0; a < 2; ++a)
#pragma unroll
            for (int b = 0; b < 2; ++b)
#pragma unroll
                for (int m = 0; m < 4; ++m)
#pragma unroll
                    for (int n = 0; n < 2; ++n) acc[a][b][m][n] = (f32x4){0.f, 0.f, 0.f, 0.f};
        cur = nxt; cA = nA; cB = nB; ++ui;
        if constexpr (ALIGN_EPI) { if (wr == 1) PG8_BAR; }
    }
    PG8_WAIT_V(0);
    if constexpr (!ALIGN_EPI) { if (wr == 0) PG8_BAR; }
    PG8_BAR;
    if constexpr (Epi::AFTER_DRAIN) { E.fused(acc, cur, wr, wc, fr, fq, lds, wid, lane); S.done(cur); }
#undef PG8_SA
#undef PG8_SB
#undef PG8_STAGE
#undef PG8_LDA
#undef PG8_LDB
#undef PG8_MMA
#undef PG8_WAIT_V
#undef PG8_WAIT_L
#undef PG8_BAR
#undef PG8_SCHED
}
}

typedef f32x4 AccT[2][2][4][2];
struct EpiBf16Plain {
    static constexpr bool PERM = false, AFTER_DRAIN = false;
    bf16* O; int ldc;
    __device__ __forceinline__ void operator()(const AccT& acc, const pg8::Unit& u, int wr, int wc, int fr, int fq) const {
        const int row0 = u.pm * 256 + wr * 64 + fr, col0 = u.pn * 256 + wc * 32 + 4 * fq;
#pragma unroll
        for (int ai = 0; ai < 2; ++ai)
#pragma unroll
            for (int m = 0; m < 4; ++m) { bf16* rowp = O + (size_t)(row0 + ai * 128 + m * 16) * ldc + col0;
#pragma unroll
                for (int bj = 0; bj < 2; ++bj)
#pragma unroll
                    for (int n = 0; n < 2; ++n) { const f32x4 v = acc[ai][bj][m][n]; u32x2 w; w.x = pk2(v[0], v[1]); w.y = pk2(v[2], v[3]); *(u32x2*)(rowp + bj * 128 + n * 16) = w; } }
    }
};
struct EpiResF32 {
    static constexpr bool PERM = false, AFTER_DRAIN = false;
    const float* base; float* out; int ldc;
    __device__ __forceinline__ void operator()(const AccT& acc, const pg8::Unit& u, int wr, int wc, int fr, int fq) const {
        const int row0 = u.pm * 256 + wr * 64 + fr, col0 = u.pn * 256 + wc * 32 + 4 * fq;
#pragma unroll
        for (int ai = 0; ai < 2; ++ai)
#pragma unroll
            for (int m = 0; m < 4; ++m) { const size_t off = (size_t)(row0 + ai * 128 + m * 16) * ldc + col0;
#pragma unroll
                for (int bj = 0; bj < 2; ++bj)
#pragma unroll
                    for (int n = 0; n < 2; ++n) { const f32x4 b = *(const f32x4*)(base + off + bj * 128 + n * 16); *(f32x4*)(out + off + bj * 128 + n * 16) = b + acc[ai][bj][m][n]; } }
    }
};
struct EpiSwiGLU {
    static constexpr bool PERM = false, AFTER_DRAIN = false;
    bf16* H;
    __device__ __forceinline__ void operator()(const AccT& acc, const pg8::Unit& u, int wr, int wc, int fr, int fq) const {
        const int row0 = u.pm * 256 + wr * 64 + fr;
#pragma unroll
        for (int ai = 0; ai < 2; ++ai)
#pragma unroll
            for (int m = 0; m < 4; ++m) { bf16* rowp = H + (size_t)(row0 + ai * 128 + m * 16) * DE;
#pragma unroll
                for (int bj = 0; bj < 2; ++bj) { const f32x4 a = acc[ai][bj][m][0], b = acc[ai][bj][m][1]; float h[4];
#pragma unroll
                    for (int r = 0; r < 4; ++r) h[r] = a[r] / (1.f + __expf(-a[r])) * b[r];
                    u32x2 w; w.x = pk2(h[0], h[1]); w.y = pk2(h[2], h[3]);
                    *(u32x2*)(rowp + 16 * (u.pn * 8 + 4 * bj + wc) + 4 * fq) = w; } }
    }
};
struct EpiMoeOut {
    static constexpr bool PERM = false, AFTER_DRAIN = false;
    bf16* Y; const int* rowtok; const float* wtop;
    __device__ __forceinline__ void operator()(const AccT& acc, const pg8::Unit& u, int wr, int wc, int fr, int fq) const {
        const int row0 = u.pm * 256 + wr * 64 + fr, col0 = u.pn * 256 + wc * 32 + 4 * fq;
#pragma unroll
        for (int ai = 0; ai < 2; ++ai)
#pragma unroll
            for (int m = 0; m < 4; ++m) { const int tk = rowtok[row0 + ai * 128 + m * 16];
                if (tk >= 0) { const float w = wtop[tk]; bf16* rowp = Y + (size_t)tk * DM + col0;
#pragma unroll
                    for (int bj = 0; bj < 2; ++bj)
#pragma unroll
                        for (int n = 0; n < 2; ++n) { const f32x4 v = acc[ai][bj][m][n] * w; u32x2 q; q.x = pk2(v[0], v[1]); q.y = pk2(v[2], v[3]); *(u32x2*)(rowp + bj * 128 + n * 16) = q; } } }
    }
};
struct EpiGate {
    static constexpr bool PERM = false, AFTER_DRAIN = false;
    float* out; const bf16* PE; const float* bias;
    __device__ __forceinline__ void operator()(const AccT& acc, const pg8::Unit& u, int wr, int wc, int fr, int fq) const {
        const int row0 = u.pm * 256 + wr * 64 + fr, col0 = u.pn * 256 + wc * 32 + 4 * fq;
        f32x4 bv[2][2];
#pragma unroll
        for (int bj = 0; bj < 2; ++bj)
#pragma unroll
            for (int n = 0; n < 2; ++n) bv[bj][n] = *(const f32x4*)(bias + col0 + bj * 128 + n * 16);
#pragma unroll
        for (int ai = 0; ai < 2; ++ai)
#pragma unroll
            for (int m = 0; m < 4; ++m) { const size_t off = (size_t)(row0 + ai * 128 + m * 16) * DM + col0;
#pragma unroll
                for (int bj = 0; bj < 2; ++bj)
#pragma unroll
                    for (int n = 0; n < 2; ++n) { const size_t o2 = off + bj * 128 + n * 16;
                        const f32x4 h2 = *(const f32x4*)(out + o2); const u32x2 pw = *(const u32x2*)(PE + o2); const f32x4 z = acc[ai][bj][m][n] + bv[bj][n];
                        f32x4 r; r[0] = h2[0] + bflo(pw.x) / (1.f + __expf(-z[0])); r[1] = h2[1] + bfhi(pw.x) / (1.f + __expf(-z[1]));
                        r[2] = h2[2] + bflo(pw.y) / (1.f + __expf(-z[2])); r[3] = h2[3] + bfhi(pw.y) / (1.f + __expf(-z[3]));
                        *(f32x4*)(out + o2) = r; } }
    }
};
#define XB_TMO      128
#define XB_XCNT(j)  (256  + 64 * (j))
#define XB_XSUB(j)  (1280 + 64 * (j))
#define XB_XGEN(j)  (2304 + 64 * (j))
#define XB_TOP      3328
#define XB_TOPGEN   3392
#define XCD_BAR_WORDS 3456
#define XB_SPIN_CAP (1u << 22)

__device__ __forceinline__ unsigned xb_ld(unsigned* p)              { return __hip_atomic_load(p, __ATOMIC_RELAXED, __HIP_MEMORY_SCOPE_AGENT); }
__device__ __forceinline__ unsigned xb_add(unsigned* p, unsigned v) { return __hip_atomic_fetch_add(p, v, __ATOMIC_RELAXED, __HIP_MEMORY_SCOPE_AGENT); }
__device__ __forceinline__ unsigned xb_xcc_id() { return (unsigned)__builtin_amdgcn_s_getreg((3 << 11) | 20) & 0xFu; }
#define XB_SPIN(cond, bar) do { unsigned _sp = 0; while (cond) { __builtin_amdgcn_s_sleep(1); \
    if ((++_sp & 255u) == 0u) { if (xb_ld(&(bar)[XB_TMO])) break; if (_sp > XB_SPIN_CAP) { atomicAdd(&(bar)[XB_TMO], 1u); break; } } } } while (0)

struct XcdBarrier {
    unsigned* bar; unsigned x;
    volatile LAS unsigned* st;
};

__device__ __forceinline__ XcdBarrier xcd_barrier_post(unsigned* bar, volatile LAS unsigned* st) {
    XcdBarrier b; b.bar = bar; b.x = xb_xcc_id(); b.st = st;
    if (threadIdx.x == 0) (void)xb_add(&bar[XB_XCNT(b.x)], 1u);
    return b;
}
__device__ __forceinline__ void xcd_barrier_complete(unsigned* bar, unsigned x, unsigned& nloc, unsigned& nx) {
    const unsigned G = gridDim.x * gridDim.y * gridDim.z;
    unsigned sum, cnt, mine, sp = 0u;
    for (;;) {
        sum = 0u; cnt = 0u; mine = 0u;
#pragma unroll
        for (unsigned j = 0; j < 16; ++j) { const unsigned c = xb_ld(&bar[XB_XCNT(j)]); sum += c; cnt += (c > 0u) ? 1u : 0u; mine = (j == x) ? c : mine; }
        if (sum == G) break;
        __builtin_amdgcn_s_sleep(1);
        if ((++sp & 255u) == 0u) { if (xb_ld(&bar[XB_TMO])) break; if (sp > XB_SPIN_CAP) { atomicAdd(&bar[XB_TMO], 1u); break; } }
    }
    nloc = mine > 0u ? mine : 1u; nx = cnt > 0u ? cnt : 1u;
}

__device__ __forceinline__ void xcd_barrier(const XcdBarrier& b) {
    asm volatile("s_waitcnt vmcnt(0)" ::: "memory");
    __syncthreads();
    if (threadIdx.x == 0) {
        unsigned* bar = b.bar;
        __builtin_amdgcn_s_waitcnt(0);
        unsigned nloc = b.st[0], nx = b.st[1];
        if (nloc == 0u) { xcd_barrier_complete(bar, b.x, nloc, nx); b.st[0] = nloc; b.st[1] = nx; }
        const unsigned old = xb_add(&bar[XB_XSUB(b.x)], 1u);
        const unsigned gen = old / nloc;
        if (old + 1u == (gen + 1u) * nloc) {
            __builtin_amdgcn_fence(__ATOMIC_RELEASE, "agent");
            asm volatile("s_waitcnt vmcnt(0)" ::: "memory");
            const unsigned og = xb_add(&bar[XB_TOP], 1u);
            const unsigned tg = og / nx;
            if (og + 1u == (tg + 1u) * nx) xb_add(&bar[XB_TOPGEN], 1u);
            else XB_SPIN(xb_ld(&bar[XB_TOPGEN]) == tg, bar);
            __builtin_amdgcn_fence(__ATOMIC_ACQUIRE, "agent");
            xb_add(&bar[XB_XGEN(b.x)], 1u);
            asm volatile("s_waitcnt vmcnt(0)" ::: "memory");
        } else {
            XB_SPIN(xb_ld(&bar[XB_XGEN(b.x)]) == gen, bar);
            __builtin_amdgcn_fence(__ATOMIC_ACQUIRE, "agent");
            asm volatile("s_waitcnt vmcnt(0)" ::: "memory");
        }
    }
    __syncthreads();
}

namespace att {
constexpr int DQ = 192, NW = 8, QBLK = 32, KVBLK = 64;
constexpr float SCALE = 0.07216878364870322f;
constexpr float THR = 8.f;
constexpr int LDQ = 2048, LDKK = 192, LDV = 2048, LDO = 1024;
constexpr int SHM_V = KVBLK * 128 * 2, SHM_K = KVBLK * DQ * 2, SHM_ATTN = 2 * SHM_V + 2 * SHM_K + NW * 64 * 4;
#define KSWZ(row, colB) ((row) * 384 + ((colB) ^ (((row) & 7) << 4)))
#define SBAR() __builtin_amdgcn_sched_barrier(0)
__device__ __forceinline__ int crow(int r, int hi) { return (r & 3) + 8 * (r >> 2) + 4 * hi; }
__device__ __forceinline__ unsigned cvtpk(float lo, float hi) { unsigned r; asm volatile("v_cvt_pk_bf16_f32 %0, %1, %2" : "=v"(r) : "v"(lo), "v"(hi)); return r; }

__device__ __forceinline__ void partialSM(f32x16& p0, f32x16& p1, float& m_reg, float& mn, float& alpha) {
  constexpr float C = SCALE * 1.4426950408889634f;
  float pmax = p0[0];
#pragma unroll
  for (int r = 1; r < 16; ++r) pmax = fmaxf(pmax, p0[r]);
#pragma unroll
  for (int r = 0; r < 16; ++r) pmax = fmaxf(pmax, p1[r]);
  { auto rr = __builtin_amdgcn_permlane32_swap(__float_as_uint(pmax), __float_as_uint(pmax), false, false);
    pmax = fmaxf(__uint_as_float(rr[0]), __uint_as_float(rr[1])); }
  if (__builtin_expect(__all(pmax - m_reg <= THR / SCALE), 1)) { mn = m_reg; alpha = 1.f; }
  else { mn = fmaxf(m_reg, pmax); alpha = __builtin_amdgcn_exp2f((m_reg - mn) * C); m_reg = mn; }
  float mnC = -mn * C;
#pragma unroll
  for (int r = 0; r < 16; ++r) p0[r] = fmaf(p0[r], C, mnC);
#pragma unroll
  for (int r = 0; r < 16; ++r) p1[r] = fmaf(p1[r], C, mnC);
#pragma unroll
  for (int r = 0; r < 16; ++r) p0[r] = __builtin_amdgcn_exp2f(p0[r]);
}
__device__ __forceinline__ void finishSM(f32x16& p0, f32x16& p1, float alpha, float& l_reg, bf16x8& pa0, bf16x8& pa1, bf16x8& pa2, bf16x8& pa3) {
#pragma unroll
  for (int r = 0; r < 16; ++r) p1[r] = __builtin_amdgcn_exp2f(p1[r]);
  float ps = 0;
#pragma unroll
  for (int r = 0; r < 16; ++r) ps += p0[r];
#pragma unroll
  for (int r = 0; r < 16; ++r) ps += p1[r];
  { auto rr = __builtin_amdgcn_permlane32_swap(__float_as_uint(ps), __float_as_uint(ps), false, false);
    ps = __uint_as_float(rr[0]) + __uint_as_float(rr[1]); }
  l_reg = l_reg * alpha + ps;
#define PK4(P, BASE, OUT) do { unsigned a0 = cvtpk(P[BASE + 0], P[BASE + 1]), a1 = cvtpk(P[BASE + 2], P[BASE + 3]);   \
    unsigned b0 = cvtpk(P[BASE + 4], P[BASE + 5]), b1 = cvtpk(P[BASE + 6], P[BASE + 7]);                              \
    auto r0 = __builtin_amdgcn_permlane32_swap(a0, b0, false, false); auto r1 = __builtin_amdgcn_permlane32_swap(a1, b1, false, false); \
    u32x4 w = {r0[0], r1[0], r0[1], r1[1]}; OUT = *reinterpret_cast<bf16x8*>(&w); } while (0)
  PK4(p0, 0, pa0); PK4(p0, 8, pa1); PK4(p1, 0, pa2); PK4(p1, 8, pa3);
#undef PK4
}
__device__ __forceinline__ void qkt(f32x16& p0, f32x16& p1, const char* Ks, const bf16x8* qr, int r32, int hi, bool dead) {
  p0 = f32x16{}; p1 = f32x16{};
#pragma unroll
  for (int d0 = 0; d0 < 12; ++d0) { const int cb = (d0 * 16 + hi * 8) * 2;
    bf16x8 b0 = *reinterpret_cast<const bf16x8*>(Ks + KSWZ(r32, cb));
    bf16x8 b1 = *reinterpret_cast<const bf16x8*>(Ks + KSWZ(32 + r32, cb));
    p0 = __builtin_amdgcn_mfma_f32_32x32x16_bf16(b0, qr[d0], p0, 0, 0, 0);
    p1 = __builtin_amdgcn_mfma_f32_32x32x16_bf16(b1, qr[d0], p1, 0, 0, 0);
    if ((d0 & 3) == 3) SBAR(); }
  if (dead) {
#pragma unroll
    for (int r = 0; r < 16; ++r) { p0[r] = -1e30f; p1[r] = -1e30f; } }
}
__device__ __forceinline__ int v_st(int k, int c) { const int kk = (k & ~0xC) | ((k & 4) << 1) | ((k & 8) >> 1); return ((kk >> 3) * 4 + (c >> 5)) * 512 + ((kk & 7) * 32 + (c & 31)) * 2; }
__device__ __forceinline__ int v_rd_base(int lane) { return ((lane & 3) << 3) | (((lane >> 2) & 3) << 6) | (((lane >> 4) & 1) << 5) | (((lane >> 5) & 1) << 8); }
constexpr int v_rd_off(int d0, int ks, int half) { return d0 * 512 + ks * 4096 + half * 2048; }
template <int OFF> __device__ __forceinline__ s16x4 tr_read(int vb) {
  s16x4 r; asm volatile("ds_read_b64_tr_b16 %0, %1 offset:%2" : "=&v"(r) : "v"(vb), "i"(OFF) : "memory"); return r;
}
template <int D0> __device__ __forceinline__ void pv_one(f32x16& od, int vb, bf16x8 pa0, bf16x8 pa1, bf16x8 pa2, bf16x8 pa3) {
  const s16x4 l0 = tr_read<v_rd_off(D0, 0, 0)>(vb), h0 = tr_read<v_rd_off(D0, 0, 1)>(vb), l1 = tr_read<v_rd_off(D0, 1, 0)>(vb), h1 = tr_read<v_rd_off(D0, 1, 1)>(vb);
  const s16x4 l2 = tr_read<v_rd_off(D0, 2, 0)>(vb), h2 = tr_read<v_rd_off(D0, 2, 1)>(vb), l3 = tr_read<v_rd_off(D0, 3, 0)>(vb), h3 = tr_read<v_rd_off(D0, 3, 1)>(vb);
  asm volatile("s_waitcnt lgkmcnt(0)" ::: "memory"); SBAR();
#define PK(L, H) (bf16x8){L[0], L[1], L[2], L[3], H[0], H[1], H[2], H[3]}
  od = __builtin_amdgcn_mfma_f32_32x32x16_bf16(pa0, PK(l0, h0), od, 0, 0, 0);
  od = __builtin_amdgcn_mfma_f32_32x32x16_bf16(pa1, PK(l1, h1), od, 0, 0, 0);
  od = __builtin_amdgcn_mfma_f32_32x32x16_bf16(pa2, PK(l2, h2), od, 0, 0, 0);
  od = __builtin_amdgcn_mfma_f32_32x32x16_bf16(pa3, PK(l3, h3), od, 0, 0, 0);
#undef PK
}
__device__ __forceinline__ void pv_d0(f32x16* o, int vb, bf16x8 pa0, bf16x8 pa1, bf16x8 pa2, bf16x8 pa3) {
  pv_one<0>(o[0], vb, pa0, pa1, pa2, pa3); pv_one<1>(o[1], vb, pa0, pa1, pa2, pa3); pv_one<2>(o[2], vb, pa0, pa1, pa2, pa3); pv_one<3>(o[3], vb, pa0, pa1, pa2, pa3);
}

__device__ __forceinline__ void attn_unit(const bf16* __restrict__ Qb, const float* __restrict__ gq, const float* __restrict__ CSq, const bf16* __restrict__ Kh, const bf16* __restrict__ Vh, bf16* __restrict__ Ob, int qb, char* lds) {
  int tid_ = threadIdx.x; asm volatile("" : "+v"(tid_));
  const int tid = tid_, wid = tid >> 6, lane = tid & 63, r32 = lane & 31, hi = lane >> 5;
  char* V_lds = lds; char* K_lds = lds + 2 * SHM_V;
  float* ws = (float*)(lds + 2 * SHM_V + 2 * SHM_K) + wid * 64; float* li_l = ws; float* al_l = ws + 32;
  float m_reg = -1e30f, l_reg = 0; f32x16 o[4] = {}; bf16x8 qr[12];
  {
    const bf16* Qw = Qb + (long)(wid * QBLK + r32) * LDQ + hi * 8; const float* cs = CSq + (long)(wid * QBLK + r32) * 64;
    u32x4 x[12];
#pragma unroll
    for (int d0 = 0; d0 < 12; ++d0) x[d0] = *reinterpret_cast<const u32x4*>(Qw + d0 * 16);
    float ss = 0.f;
#pragma unroll
    for (int d0 = 0; d0 < 12; ++d0) { const float v0 = bflo(x[d0].x), v1 = bfhi(x[d0].x), v2 = bflo(x[d0].y), v3 = bfhi(x[d0].y), v4 = bflo(x[d0].z), v5 = bfhi(x[d0].z), v6 = bflo(x[d0].w), v7 = bfhi(x[d0].w);
      ss += (v0 * v0 + v1 * v1) + (v2 * v2 + v3 * v3) + (v4 * v4 + v5 * v5) + (v6 * v6 + v7 * v7); }
    ss += __shfl_xor(ss, 32);
    const float rs = 1.0f / sqrtf(ss * (1.f / 192.f) + 1e-6f);
#pragma unroll
    for (int d0 = 0; d0 < 8; ++d0) { const f32x4 g0 = *(const f32x4*)(gq + 16 * d0 + 8 * hi), g1 = *(const f32x4*)(gq + 16 * d0 + 8 * hi + 4); u32x4 w;
      w.x = pk2(bflo(x[d0].x) * rs * g0.x, bfhi(x[d0].x) * rs * g0.y); w.y = pk2(bflo(x[d0].y) * rs * g0.z, bfhi(x[d0].y) * rs * g0.w);
      w.z = pk2(bflo(x[d0].z) * rs * g1.x, bfhi(x[d0].z) * rs * g1.y); w.w = pk2(bflo(x[d0].w) * rs * g1.z, bfhi(x[d0].w) * rs * g1.w);
      qr[d0] = __builtin_bit_cast(bf16x8, w); }
#pragma unroll
    for (int p = 0; p < 2; ++p) {
      const int i0 = 16 * p + 8 * hi; float x1[8], x2[8], c[8], sn[8], y1[8], y2[8];
      { const u32x4 u = x[8 + p], v = x[10 + p];
        x1[0] = bflo(u.x); x1[1] = bfhi(u.x); x1[2] = bflo(u.y); x1[3] = bfhi(u.y); x1[4] = bflo(u.z); x1[5] = bfhi(u.z); x1[6] = bflo(u.w); x1[7] = bfhi(u.w);
        x2[0] = bflo(v.x); x2[1] = bfhi(v.x); x2[2] = bflo(v.y); x2[3] = bfhi(v.y); x2[4] = bflo(v.z); x2[5] = bfhi(v.z); x2[6] = bflo(v.w); x2[7] = bfhi(v.w); }
      { const f32x4 a0 = *(const f32x4*)(gq + 128 + i0), a1 = *(const f32x4*)(gq + 128 + i0 + 4), b0 = *(const f32x4*)(gq + 160 + i0), b1 = *(const f32x4*)(gq + 160 + i0 + 4);
        const f32x4 c0 = *(const f32x4*)(cs + i0), c1 = *(const f32x4*)(cs + i0 + 4), s0 = *(const f32x4*)(cs + 32 + i0), s1 = *(const f32x4*)(cs + 32 + i0 + 4);
#pragma unroll
        for (int j = 0; j < 4; ++j) { x1[j] *= rs * a0[j]; x1[4 + j] *= rs * a1[j]; x2[j] *= rs * b0[j]; x2[4 + j] *= rs * b1[j]; c[j] = c0[j]; c[4 + j] = c1[j]; sn[j] = s0[j]; sn[4 + j] = s1[j]; } }
#pragma unroll
      for (int j = 0; j < 8; ++j) { y1[j] = x1[j] * c[j] - x2[j] * sn[j]; y2[j] = x2[j] * c[j] + x1[j] * sn[j]; }
      u32x4 w1, w2; w1.x = pk2(y1[0], y1[1]); w1.y = pk2(y1[2], y1[3]); w1.z = pk2(y1[4], y1[5]); w1.w = pk2(y1[6], y1[7]);
      w2.x = pk2(y2[0], y2[1]); w2.y = pk2(y2[2], y2[3]); w2.z = pk2(y2[4], y2[5]); w2.w = pk2(y2[6], y2[7]);
      qr[8 + p] = __builtin_bit_cast(bf16x8, w1); qr[10 + p] = __builtin_bit_cast(bf16x8, w2);
    }
  }
  const int sr = tid >> 4, sc = (tid & 15) * 8, vst0 = v_st(sr, sc), vst1 = v_st(32 + sr, sc);
  const int kr = tid >> 3, kc = 128 + (tid & 7) * 8;
  const int vb0 = (int)(uintptr_t)V_lds + v_rd_base(lane);
  const int NT = 4 * qb + 4, NTw = 4 * qb + 1 + (wid >> 1);
  bf16x8 vs0, vs1, ks0, ks1, ks2;
#define SLOAD(k0) do { vs0 = *reinterpret_cast<const bf16x8*>(&Vh[(long)((k0) + sr) * LDV + sc]); vs1 = *reinterpret_cast<const bf16x8*>(&Vh[(long)((k0) + 32 + sr) * LDV + sc]); \
    ks0 = *reinterpret_cast<const bf16x8*>(&Kh[(long)((k0) + sr) * LDKK + sc]); ks1 = *reinterpret_cast<const bf16x8*>(&Kh[(long)((k0) + 32 + sr) * LDKK + sc]); \
    ks2 = *reinterpret_cast<const bf16x8*>(&Kh[(long)((k0) + kr) * LDKK + kc]); } while (0)
#define SWRITE(b) do { *(bf16x8*)(V_lds + (b) * SHM_V + vst0) = vs0; *(bf16x8*)(V_lds + (b) * SHM_V + vst1) = vs1; \
    *(bf16x8*)(K_lds + (b) * SHM_K + KSWZ(sr, sc * 2)) = ks0; *(bf16x8*)(K_lds + (b) * SHM_K + KSWZ(32 + sr, sc * 2)) = ks1; \
    *(bf16x8*)(K_lds + (b) * SHM_K + KSWZ(kr, kc * 2)) = ks2; } while (0)
#define SWAIT() asm volatile("s_waitcnt vmcnt(0)" ::: "memory")
#define RESC(a) do { if (__any((a) < 1.f)) { if (hi == 0) al_l[r32] = (a); asm volatile("s_waitcnt lgkmcnt(0)" ::: "memory"); \
    _Pragma("unroll") for (int d = 0; d < 4; ++d) _Pragma("unroll") for (int r = 0; r < 16; ++r) o[d][r] *= al_l[crow(r, hi)]; } } while (0)
  f32x16 pA0, pA1; float mnA, alA; bf16x8 pa0, pa1, pa2, pa3;
  SLOAD(0); SWAIT(); SWRITE(0); __syncthreads();
#pragma unroll 1
  for (int j = 0; j < NT; ++j) {
    const int cur = j & 1;
    if (j + 1 < NT) SLOAD((j + 1) * KVBLK);
    SBAR(); qkt(pA0, pA1, K_lds + cur * SHM_K, qr, r32, hi, j >= NTw);
    partialSM(pA0, pA1, m_reg, mnA, alA);
    RESC(alA);
    finishSM(pA0, pA1, alA, l_reg, pa0, pa1, pa2, pa3); SBAR();
    pv_d0(o, vb0 + cur * SHM_V, pa0, pa1, pa2, pa3);
    if (j + 1 < NT) { SWAIT(); SWRITE(cur ^ 1); }
    __syncthreads();
  }
  if (hi == 0) li_l[r32] = l_reg; asm volatile("s_waitcnt lgkmcnt(0)" ::: "memory");
  float rli[16];
#pragma unroll
  for (int r = 0; r < 16; ++r) rli[r] = __builtin_amdgcn_rcpf(li_l[crow(r, hi)]);
  bf16* Ow = Ob + (long)(wid * QBLK) * LDO;
#pragma unroll
  for (int r = 0; r < 16; ++r) { const int orow = crow(r, hi);
#pragma unroll
    for (int d0 = 0; d0 < 4; ++d0) Ow[(long)orow * LDO + d0 * 32 + r32] = (bf16)f2bf(o[d0][r] * rli[r]); }
  __syncthreads();
#undef SLOAD
#undef SWRITE
#undef SWAIT
#undef RESC
}
#undef SBAR
}

struct Args {
    const float* in[27]; float* out; unsigned char* ws; float freq[32];
};
__device__ __forceinline__ int launder_v(int x) { asm volatile("" : "+v"(x)); return x; }
struct Frame {
    LAS unsigned char* lds;
    volatile LAS unsigned* MISC;
    gu32* ctl;
    int tid, lane, wave, vcu, G;
};
enum { I_X = 0, I_P, I_POS, I_NORM_MIX, I_W_IN, I_G_QLAT, I_G_KVLAT, I_W_UQ, I_W_UKV, I_G_QHEAD, I_G_KHEAD, I_W_CONV, I_G_OUT_ATTN, I_G_OUT_CONV, I_W_OUT,
       I_NORM_MOE, I_W_GROUP, I_B_GROUP, I_W_ROUTER, I_B_ROUTER, I_W1, I_W3, I_W2, I_NORM_PLE, I_W_PLE, I_W_PLE_GATE, I_B_PLE_GATE };

template <int MODE> __device__ __forceinline__ int rowmap(int n) {
    if (MODE == 0) return n;
    if (MODE == 1) return (n / 192) * 256 + (n % 192);
    if (MODE == 2) return ((n >> 4) << 5) + (n & 15);
    return ((n >> 4) << 5) + 16 + (n & 15);
}
template <int MODE> __device__ __forceinline__ void transpose_item(const float* W, int K, int N, bf16* WT, LAS float* scr, int item, int lane) {
    const int nblk = N / 32, kb = item / nblk, nb = item % nblk, k0 = 64 * kb, n0 = 32 * nb;
    float tmp[32];
#pragma unroll
    for (int i = 0; i < 32; ++i) { const int kk = 2 * i + (lane >> 5); tmp[i] = __builtin_nontemporal_load(W + (size_t)(k0 + kk) * N + n0 + (lane & 31)); }
#pragma unroll
    for (int i = 0; i < 32; ++i) { const int kk = 2 * i + (lane >> 5); scr[kk * 33 + (lane & 31)] = tmp[i]; }
    LDS_WAIT(); asm volatile("" ::: "memory");
    const int c = lane & 7;
#pragma unroll
    for (int j = 0; j < 4; ++j) { const int n = (lane >> 3) + 8 * j; const LAS float* s = scr + (8 * c) * 33 + n;
        u32x4 o; o.x = pk2(s[0 * 33], s[1 * 33]); o.y = pk2(s[2 * 33], s[3 * 33]); o.z = pk2(s[4 * 33], s[5 * 33]); o.w = pk2(s[6 * 33], s[7 * 33]);
        __builtin_nontemporal_store(o, (u32x4*)(WT + (size_t)rowmap<MODE>(n0 + n) * K + k0 + 8 * c)); }
    LDS_WAIT(); asm volatile("" ::: "memory");
}
__device__ __forceinline__ void rms_row_to_bf16(const float* xrow, const float* g, bf16* orow, int lane) {
    const f32x4* xr = (const f32x4*)xrow + lane; const f32x4* gr = (const f32x4*)g + lane;
    f32x4 v[8]; float s = 0.f;
#pragma unroll
    for (int j = 0; j < 8; ++j) { v[j] = xr[64 * j]; s += (v[j].x * v[j].x + v[j].y * v[j].y) + (v[j].z * v[j].z + v[j].w * v[j].w); }
    const float rs = 1.0f / sqrtf(wave_sum(s) * (1.f / DM) + EPS);
    u32x2* o8 = (u32x2*)orow + lane;
#pragma unroll
    for (int j = 0; j < 8; ++j) { const f32x4 gg = gr[64 * j]; u32x2 w; w.x = pk2(v[j].x * rs * gg.x, v[j].y * rs * gg.y); w.y = pk2(v[j].z * rs * gg.z, v[j].w * rs * gg.w); o8[64 * j] = w; }
}

__device__ __forceinline__ void p0_prologue(Frame& F, const Args& a) {
    unsigned char* ws = a.ws;
    LAS float* scr = (LAS float*)(F.lds + RING_OFF + F.wave * 16384);
    const int gw = F.vcu * NWAVES + F.wave, NGW = F.G * NWAVES, lane = launder_v(F.lane);
    bf16* WinT = (bf16*)(ws + WS_WIN); bf16* WuqT = (bf16*)(ws + WS_WUQ); bf16* WukvT = (bf16*)(ws + WS_WUKV); bf16* WpleT = (bf16*)(ws + WS_WPLE);
    bf16* WoutT = (bf16*)(ws + WS_WOUT); bf16* WpgT = (bf16*)(ws + WS_WPG); bf16* W13T = (bf16*)(ws + WS_W13); bf16* W2T = (bf16*)(ws + WS_W2);
    constexpr int I_IN = (DM / 64) * (DIN / 32), I_UQ = (QR / 64) * (NH * QKH / 32), I_UKV = (KVR / 64) * (DM / 32), I_OUT = (DM / 64) * (DM / 32), I_PG = I_OUT, I_PL = (PLE / 64) * (DM / 32);
    constexpr int I_E1 = (DM / 64) * (DE / 32), I_E2 = (DE / 64) * (DM / 32);
    constexpr int I_SMALL = I_IN + I_UQ + I_UKV + I_OUT + I_PG + I_PL;
    constexpr int NITEMS = I_SMALL;
    for (int it = gw; it < NITEMS; it += NGW) {
        int r = it;
        if (r < I_IN) { transpose_item<0>(a.in[I_W_IN], DM, DIN, WinT, scr, r, lane); continue; } r -= I_IN;
        if (r < I_UQ) { transpose_item<1>(a.in[I_W_UQ], QR, NH * QKH, WuqT, scr, r, lane); continue; } r -= I_UQ;
        if (r < I_UKV) { transpose_item<0>(a.in[I_W_UKV], KVR, DM, WukvT, scr, r, lane); continue; } r -= I_UKV;
        if (r < I_OUT) { transpose_item<0>(a.in[I_W_OUT], DM, DM, WoutT, scr, r, lane); continue; } r -= I_OUT;
        if (r < I_PG) { transpose_item<0>(a.in[I_W_PLE_GATE], DM, DM, WpgT, scr, r, lane); continue; } r -= I_PG;
        if (r < I_PL) { transpose_item<0>(a.in[I_W_PLE], PLE, DM, WpleT, scr, r, lane); continue; } r -= I_PL;
    }
    {
        const int gt = (F.vcu * NWAVES + F.wave) * 64 + lane, NGT = NGW * 64;
        const u32x4 z = {0u, 0u, 0u, 0u};
        for (int i = gt; i < (DINP - DIN) * DM / 8; i += NGT) *(u32x4*)(WinT + (size_t)DIN * DM + (size_t)i * 8) = z;
        for (int i = gt; i < NH * 64 * QR / 8; i += NGT) { const int h = i / (64 * QR / 8), rr = i % (64 * QR / 8); *(u32x4*)(WuqT + ((size_t)h * 256 + 192) * QR + (size_t)rr * 8) = z; }
        const float* p = a.in[I_P]; bf16* Pb = (bf16*)(ws + WS_PB);
        for (int i = gt; i < T_TOK * PLE / 8; i += NGT) { const f32x4 x0 = *(const f32x4*)(p + (size_t)i * 8), x1 = *(const f32x4*)(p + (size_t)i * 8 + 4);
            u32x4 w; w.x = pk2(x0.x, x0.y); w.y = pk2(x0.z, x0.w); w.z = pk2(x1.x, x1.y); w.w = pk2(x1.z, x1.w); *(u32x4*)(Pb + (size_t)i * 8) = w; }
        const int* pos = (const int*)a.in[I_POS]; float* CS = (float*)(ws + WS_CS);
        for (int i = gt; i < T_TOK * 32; i += NGT) { const int t = i >> 5, fi = i & 31;
            const float ang = (float)pos[t] * a.freq[fi];
            const double rev = (double)ang * 0.15915494309189535; const float fr = (float)(rev - rint(rev));
            CS[t * 64 + fi] = __builtin_amdgcn_cosf(fr); CS[t * 64 + 32 + fi] = __builtin_amdgcn_sinf(fr); }
    }
    bf16* XN = (bf16*)(ws + WS_R1);
    for (int m = gw; m < T_TOK; m += NGW) rms_row_to_bf16(a.in[I_X] + (size_t)m * DM, a.in[I_NORM_MIX], XN + (size_t)m * DM, lane);
}

__device__ __forceinline__ void moe_convert_dyn(Frame& F, const Args& a) {
    unsigned char* ws = a.ws;
    LAS float* scr = (LAS float*)(F.lds + RING_OFF + F.wave * 16384);
    bf16* W13T = (bf16*)(ws + WS_W13); bf16* W2T = (bf16*)(ws + WS_W2);
    constexpr int I_E1 = (DM / 64) * (DE / 32), I_E2 = (DE / 64) * (DM / 32), PER_E = 2 * I_E1 + I_E2, NIT = NE * PER_E;
    unsigned* ctr = (unsigned*)(ws + WS_CTL) + CW_QCONV;
    volatile LAS unsigned* slot = F.MISC + 12;
    const int lane = launder_v(F.lane);
    for (;;) {
        if (F.tid == 0) slot[0] = atomicAdd(ctr, 64u);
        __syncthreads();
        const int base = (int)slot[0];
        __syncthreads();
        if (base >= NIT) break;
#pragma unroll 1
        for (int q = 0; q < 8; ++q) {
            const int it = base + F.wave * 8 + q; if (it >= NIT) break;
            const int e = it / PER_E; int r = it - e * PER_E;
            if (r < I_E1) transpose_item<2>(a.in[I_W1] + (size_t)e * DM * DE, DM, DE, W13T + (size_t)e * 1024 * DM, scr, r, lane);
            else if (r < 2 * I_E1) transpose_item<3>(a.in[I_W3] + (size_t)e * DM * DE, DM, DE, W13T + (size_t)e * 1024 * DM, scr, r - I_E1, lane);
            else transpose_item<0>(a.in[I_W2] + (size_t)e * DE * DM, DE, DM, W2T + (size_t)e * DM * DE, scr, r - 2 * I_E1, lane);
        }
    }
}

__device__ __forceinline__ void p2a_rows(Frame& F, const Args& a) {
    unsigned char* ws = a.ws;
    const bf16* PROJ = (const bf16*)(ws + WS_R2); bf16* QLN = (bf16*)(ws + WS_QLN); bf16* KVLN = (bf16*)(ws + WS_KVLN); bf16* YMIX = (bf16*)(ws + WS_R4);
    const float* gq = a.in[I_G_QLAT]; const float* gkv = a.in[I_G_KVLAT]; const float* wconv = a.in[I_W_CONV]; const float* gc = a.in[I_G_OUT_CONV];
    const int gw = F.vcu * NWAVES + F.wave, NGW = F.G * NWAVES, lane = launder_v(F.lane);
    for (int t = gw; t < T_TOK; t += NGW) {
        const bf16* pr = PROJ + (size_t)t * DINP; const int s = t & (SEQ - 1);
        {
            const u32x4 w = *(const u32x4*)(pr + OFF_QLAT + lane * 8);
            float v[8] = {bflo(w.x), bfhi(w.x), bflo(w.y), bfhi(w.y), bflo(w.z), bfhi(w.z), bflo(w.w), bfhi(w.w)}; float ss = 0.f;
#pragma unroll
            for (int i = 0; i < 8; ++i) ss += v[i] * v[i];
            const float rs = 1.0f / sqrtf(wave_sum(ss) * (1.f / QR) + EPS);
            const f32x4 g0 = *(const f32x4*)(gq + lane * 8), g1 = *(const f32x4*)(gq + lane * 8 + 4);
            u32x4 o; o.x = pk2(v[0] * rs * g0.x, v[1] * rs * g0.y); o.y = pk2(v[2] * rs * g0.z, v[3] * rs * g0.w); o.z = pk2(v[4] * rs * g1.x, v[5] * rs * g1.y); o.w = pk2(v[6] * rs * g1.z, v[7] * rs * g1.w);
            *(u32x4*)(QLN + (size_t)t * QR + lane * 8) = o;
        }
        {
            const u32x2 w = *(const u32x2*)(pr + OFF_KVLAT + lane * 4);
            float v[4] = {bflo(w.x), bfhi(w.x), bflo(w.y), bfhi(w.y)}; float ss = (v[0] * v[0] + v[1] * v[1]) + (v[2] * v[2] + v[3] * v[3]);
            const float rs = 1.0f / sqrtf(wave_sum(ss) * (1.f / KVR) + EPS);
            const f32x4 g0 = *(const f32x4*)(gkv + lane * 4);
            u32x2 o; o.x = pk2(v[0] * rs * g0.x, v[1] * rs * g0.y); o.y = pk2(v[2] * rs * g0.z, v[3] * rs * g0.w);
            *(u32x2*)(KVLN + (size_t)t * KVR + lane * 4) = o;
        }
        {
            float y[16]; float ss = 0.f;
#pragma unroll
            for (int j = 0; j < 2; ++j) { const int ch = lane * 8 + 512 * j;
                float u0[8], u1[8], u2[8], bb[8];
                { const u32x4 c = *(const u32x4*)(pr + OFF_C + ch), h = *(const u32x4*)(pr + OFF_H + ch), b = *(const u32x4*)(pr + OFF_B + ch);
                  u2[0] = bflo(c.x) * bflo(h.x); u2[1] = bfhi(c.x) * bfhi(h.x); u2[2] = bflo(c.y) * bflo(h.y); u2[3] = bfhi(c.y) * bfhi(h.y);
                  u2[4] = bflo(c.z) * bflo(h.z); u2[5] = bfhi(c.z) * bfhi(h.z); u2[6] = bflo(c.w) * bflo(h.w); u2[7] = bfhi(c.w) * bfhi(h.w);
                  bb[0] = bflo(b.x); bb[1] = bfhi(b.x); bb[2] = bflo(b.y); bb[3] = bfhi(b.y); bb[4] = bflo(b.z); bb[5] = bfhi(b.z); bb[6] = bflo(b.w); bb[7] = bfhi(b.w); }
                if (s >= 1) { const bf16* p1 = pr - DINP; const u32x4 c = *(const u32x4*)(p1 + OFF_C + ch), h = *(const u32x4*)(p1 + OFF_H + ch);
                  u1[0] = bflo(c.x) * bflo(h.x); u1[1] = bfhi(c.x) * bfhi(h.x); u1[2] = bflo(c.y) * bflo(h.y); u1[3] = bfhi(c.y) * bfhi(h.y);
                  u1[4] = bflo(c.z) * bflo(h.z); u1[5] = bfhi(c.z) * bfhi(h.z); u1[6] = bflo(c.w) * bflo(h.w); u1[7] = bfhi(c.w) * bfhi(h.w); }
                else {
#pragma unroll
                  for (int i = 0; i < 8; ++i) u1[i] = 0.f; }
                if (s >= 2) { const bf16* p2 = pr - 2 * DINP; const u32x4 c = *(const u32x4*)(p2 + OFF_C + ch), h = *(const u32x4*)(p2 + OFF_H + ch);
                  u0[0] = bflo(c.x) * bflo(h.x); u0[1] = bfhi(c.x) * bfhi(h.x); u0[2] = bflo(c.y) * bflo(h.y); u0[3] = bfhi(c.y) * bfhi(h.y);
                  u0[4] = bflo(c.z) * bflo(h.z); u0[5] = bfhi(c.z) * bfhi(h.z); u0[6] = bflo(c.w) * bflo(h.w); u0[7] = bfhi(c.w) * bfhi(h.w); }
                else {
#pragma unroll
                  for (int i = 0; i < 8; ++i) u0[i] = 0.f; }
                float w0[8], w1[8], w2[8];
                { const f32x4 a0 = *(const f32x4*)(wconv + ch), a1 = *(const f32x4*)(wconv + ch + 4); w0[0] = a0.x; w0[1] = a0.y; w0[2] = a0.z; w0[3] = a0.w; w0[4] = a1.x; w0[5] = a1.y; w0[6] = a1.z; w0[7] = a1.w; }
                { const f32x4 a0 = *(const f32x4*)(wconv + DC + ch), a1 = *(const f32x4*)(wconv + DC + ch + 4); w1[0] = a0.x; w1[1] = a0.y; w1[2] = a0.z; w1[3] = a0.w; w1[4] = a1.x; w1[5] = a1.y; w1[6] = a1.z; w1[7] = a1.w; }
                { const f32x4 a0 = *(const f32x4*)(wconv + 2 * DC + ch), a1 = *(const f32x4*)(wconv + 2 * DC + ch + 4); w2[0] = a0.x; w2[1] = a0.y; w2[2] = a0.z; w2[3] = a0.w; w2[4] = a1.x; w2[5] = a1.y; w2[6] = a1.z; w2[7] = a1.w; }
#pragma unroll
                for (int i = 0; i < 8; ++i) { const float v = bb[i] * (u0[i] * w0[i] + u1[i] * w1[i] + u2[i] * w2[i]); y[j * 8 + i] = v; ss += v * v; }
            }
            const float rs = 1.0f / sqrtf(wave_sum(ss) * (1.f / DC) + EPS);
#pragma unroll
            for (int j = 0; j < 2; ++j) { const int ch = lane * 8 + 512 * j; const f32x4 g0 = *(const f32x4*)(gc + ch), g1 = *(const f32x4*)(gc + ch + 4);
                u32x4 o; o.x = pk2(y[j * 8 + 0] * rs * g0.x, y[j * 8 + 1] * rs * g0.y); o.y = pk2(y[j * 8 + 2] * rs * g0.z, y[j * 8 + 3] * rs * g0.w);
                o.z = pk2(y[j * 8 + 4] * rs * g1.x, y[j * 8 + 5] * rs * g1.y); o.w = pk2(y[j * 8 + 6] * rs * g1.z, y[j * 8 + 7] * rs * g1.w);
                *(u32x4*)(YMIX + (size_t)t * DM + DC + ch) = o; }
        }
    }
}

__device__ __forceinline__ void p2c_k(Frame& F, const Args& a) {
    unsigned char* ws = a.ws;
    const bf16* KVRAW = (const bf16*)(ws + WS_KVRAW); const bf16* PROJ = (const bf16*)(ws + WS_R2); const float* CS = (const float*)(ws + WS_CS);
    bf16* K = (bf16*)(ws + WS_K); const float* gkh = a.in[I_G_KHEAD];
    const int gw = F.vcu * NWAVES + F.wave, NGW = F.G * NWAVES, lane = launder_v(F.lane), r32 = lane & 31, hi = lane >> 5;
    for (int it = gw; it < T_TOK * NH / 32; it += NGW) {
        const int row = it * 32 + r32, t = row >> 3, h = row & 7, b = t >> 12, sq = t & (SEQ - 1);
        const bf16* kn = KVRAW + (size_t)t * DM + h * 256 + 8 * hi; const bf16* kr = PROJ + (size_t)t * DINP + OFF_KROPE + 8 * hi;
        u32x4 x[12];
#pragma unroll
        for (int d0 = 0; d0 < 8; ++d0) x[d0] = *(const u32x4*)(kn + 16 * d0);
#pragma unroll
        for (int d0 = 0; d0 < 4; ++d0) x[8 + d0] = *(const u32x4*)(kr + 16 * d0);
        float ss = 0.f;
#pragma unroll
        for (int d0 = 0; d0 < 12; ++d0) { const float v0 = bflo(x[d0].x), v1 = bfhi(x[d0].x), v2 = bflo(x[d0].y), v3 = bfhi(x[d0].y), v4 = bflo(x[d0].z), v5 = bfhi(x[d0].z), v6 = bflo(x[d0].w), v7 = bfhi(x[d0].w);
            ss += (v0 * v0 + v1 * v1) + (v2 * v2 + v3 * v3) + (v4 * v4 + v5 * v5) + (v6 * v6 + v7 * v7); }
        ss += __shfl_xor(ss, 32);
        const float rs = 1.0f / sqrtf(ss * (1.f / QKH) + EPS);
        bf16* o = K + ((size_t)(b * NH + h) * SEQ + sq) * QKH + 8 * hi;
#pragma unroll
        for (int d0 = 0; d0 < 8; ++d0) { const f32x4 g0 = *(const f32x4*)(gkh + 16 * d0 + 8 * hi), g1 = *(const f32x4*)(gkh + 16 * d0 + 8 * hi + 4); u32x4 w;
            w.x = pk2(bflo(x[d0].x) * rs * g0.x, bfhi(x[d0].x) * rs * g0.y); w.y = pk2(bflo(x[d0].y) * rs * g0.z, bfhi(x[d0].y) * rs * g0.w);
            w.z = pk2(bflo(x[d0].z) * rs * g1.x, bfhi(x[d0].z) * rs * g1.y); w.w = pk2(bflo(x[d0].w) * rs * g1.z, bfhi(x[d0].w) * rs * g1.w);
            *(u32x4*)(o + 16 * d0) = w; }
#pragma unroll
        for (int p = 0; p < 2; ++p) {
            const int i0 = 16 * p + 8 * hi; float x1[8], x2[8], c[8], sn[8], y1[8], y2[8];
            { const u32x4 u = x[8 + p], v = x[10 + p];
              x1[0] = bflo(u.x); x1[1] = bfhi(u.x); x1[2] = bflo(u.y); x1[3] = bfhi(u.y); x1[4] = bflo(u.z); x1[5] = bfhi(u.z); x1[6] = bflo(u.w); x1[7] = bfhi(u.w);
              x2[0] = bflo(v.x); x2[1] = bfhi(v.x); x2[2] = bflo(v.y); x2[3] = bfhi(v.y); x2[4] = bflo(v.z); x2[5] = bfhi(v.z); x2[6] = bflo(v.w); x2[7] = bfhi(v.w); }
            { const f32x4 a0 = *(const f32x4*)(gkh + 128 + i0), a1 = *(const f32x4*)(gkh + 128 + i0 + 4), b0 = *(const f32x4*)(gkh + 160 + i0), b1 = *(const f32x4*)(gkh + 160 + i0 + 4);
              const f32x4 c0 = *(const f32x4*)(CS + (size_t)t * 64 + i0), c1 = *(const f32x4*)(CS + (size_t)t * 64 + i0 + 4), s0 = *(const f32x4*)(CS + (size_t)t * 64 + 32 + i0), s1 = *(const f32x4*)(CS + (size_t)t * 64 + 32 + i0 + 4);
#pragma unroll
              for (int j = 0; j < 4; ++j) { x1[j] *= rs * a0[j]; x1[4 + j] *= rs * a1[j]; x2[j] *= rs * b0[j]; x2[4 + j] *= rs * b1[j]; c[j] = c0[j]; c[4 + j] = c1[j]; sn[j] = s0[j]; sn[4 + j] = s1[j]; } }
#pragma unroll
            for (int j = 0; j < 8; ++j) { y1[j] = x1[j] * c[j] - x2[j] * sn[j]; y2[j] = x2[j] * c[j] + x1[j] * sn[j]; }
            u32x4 w1, w2; w1.x = pk2(y1[0], y1[1]); w1.y = pk2(y1[2], y1[3]); w1.z = pk2(y1[4], y1[5]); w1.w = pk2(y1[6], y1[7]);
            w2.x = pk2(y2[0], y2[1]); w2.y = pk2(y2[2], y2[3]); w2.z = pk2(y2[4], y2[5]); w2.w = pk2(y2[6], y2[7]);
            *(u32x4*)(o + 16 * (8 + p)) = w1; *(u32x4*)(o + 16 * (10 + p)) = w2;
        }
    }
}

__device__ __forceinline__ void p3b_rows(Frame& F, const Args& a) {
    unsigned char* ws = a.ws;
    const bf16* O = (const bf16*)(ws + WS_R2); bf16* YMIX = (bf16*)(ws + WS_R4); const float* ga = a.in[I_G_OUT_ATTN];
    const int gw = F.vcu * NWAVES + F.wave, NGW = F.G * NWAVES, lane = launder_v(F.lane);
    for (int t = gw; t < T_TOK; t += NGW) {
        float v[16]; float ss = 0.f;
#pragma unroll
        for (int j = 0; j < 2; ++j) { const u32x4 w = *(const u32x4*)(O + (size_t)t * 1024 + lane * 8 + 512 * j);
            v[j * 8 + 0] = bflo(w.x); v[j * 8 + 1] = bfhi(w.x); v[j * 8 + 2] = bflo(w.y); v[j * 8 + 3] = bfhi(w.y); v[j * 8 + 4] = bflo(w.z); v[j * 8 + 5] = bfhi(w.z); v[j * 8 + 6] = bflo(w.w); v[j * 8 + 7] = bfhi(w.w); }
#pragma unroll
        for (int i = 0; i < 16; ++i) ss += v[i] * v[i];
        const float rs = 1.0f / sqrtf(wave_sum(ss) * (1.f / 1024) + EPS);
#pragma unroll
        for (int j = 0; j < 2; ++j) { const int ch = lane * 8 + 512 * j; const f32x4 g0 = *(const f32x4*)(ga + ch), g1 = *(const f32x4*)(ga + ch + 4);
            u32x4 o; o.x = pk2(v[j * 8 + 0] * rs * g0.x, v[j * 8 + 1] * rs * g0.y); o.y = pk2(v[j * 8 + 2] * rs * g0.z, v[j * 8 + 3] * rs * g0.w);
            o.z = pk2(v[j * 8 + 4] * rs * g1.x, v[j * 8 + 5] * rs * g1.y); o.w = pk2(v[j * 8 + 6] * rs * g1.z, v[j * 8 + 7] * rs * g1.w);
            *(u32x4*)(YMIX + (size_t)t * DM + ch) = o; }
    }
}

typedef float f32x16r __attribute__((ext_vector_type(16)));
__device__ __forceinline__ void p5_route(Frame& F, const Args& a, bool commit) {
    unsigned char* ws = a.ws;
    const float* H1 = a.out; const float* gm = a.in[I_NORM_MOE]; float* RS = (float*)(ws + WS_RS);
    const float* wg = a.in[I_W_GROUP]; const float* bg = a.in[I_B_GROUP]; const float* wr = a.in[I_W_ROUTER]; const float* br = a.in[I_B_ROUTER];
    int* LIST = (int*)(ws + WS_LIST); float* WTOP = (float*)(ws + WS_WTOP); unsigned* cnt = (unsigned*)(ws + WS_CTL) + CW_CNT;
    LAS float* red = (LAS float*)(F.lds + RING_OFF);
    LAS float* redg = red + 8 * 32 * 33;
    LAS float* redss = redg + 8 * 32 * 4;
    LAS float* fin = redss + 8 * 32;
    const int lane = launder_v(F.lane), w = F.wave, i = lane & 31, kk = lane >> 5;
    for (int c = F.vcu; c < T_TOK / 32; c += F.G) {
        const int t0 = c * 32;
        const float* hrow = H1 + (size_t)(t0 + i) * DM + 256 * w + 4 * kk;
        f32x16r acc = {0.f, 0.f, 0.f, 0.f, 0.f, 0.f, 0.f, 0.f, 0.f, 0.f, 0.f, 0.f, 0.f, 0.f, 0.f, 0.f};
        float ss = 0.f; f32x4 g4 = {0.f, 0.f, 0.f, 0.f};
#pragma unroll 4
        for (int s = 0; s < 32; ++s) {
            const int kb = 256 * w + 8 * s + 4 * kk;
            const f32x4 h = *(const f32x4*)(hrow + 8 * s); const f32x4 gk = *(const f32x4*)(gm + kb);
            ss += (h.x * h.x + h.y * h.y) + (h.z * h.z + h.w * h.w);
            const f32x4 av = h * gk;
#pragma unroll
            for (int q = 0; q < 4; ++q) { const float bq = wr[(size_t)(kb + q) * NE + i]; const f32x4 wgk = *(const f32x4*)(wg + (size_t)(kb + q) * 4);
                acc = __builtin_amdgcn_mfma_f32_32x32x2f32(av[q], bq, acc, 0, 0, 0); g4 += wgk * av[q]; }
        }
        ss += __shfl_xor(ss, 32);
#pragma unroll
        for (int q = 0; q < 4; ++q) g4[q] += __shfl_xor(g4[q], 32);
#pragma unroll
        for (int r = 0; r < 16; ++r) red[(w * 32 + (r & 3) + 8 * (r >> 2) + 4 * kk) * 33 + i] = acc[r];
        if (kk == 0) { redss[w * 32 + i] = ss;
#pragma unroll
            for (int q = 0; q < 4; ++q) redg[(w * 32 + i) * 4 + q] = g4[q]; }
        __syncthreads();
        {
            const int ti = F.tid >> 4, jq = F.tid & 15; float s0 = 0.f, s1 = 0.f, s2 = 0.f;
#pragma unroll
            for (int ww = 0; ww < 8; ++ww) { s0 += red[(ww * 32 + ti) * 33 + jq]; s1 += red[(ww * 32 + ti) * 33 + jq + 16];
                if (jq < 4) s2 += redg[(ww * 32 + ti) * 4 + jq]; else if (jq == 4) s2 += redss[ww * 32 + ti]; }
            fin[ti * 40 + jq] = s0; fin[ti * 40 + jq + 16] = s1; if (jq < 5) fin[ti * 40 + 32 + jq] = s2;
        }
        __syncthreads();
        if (F.tid < 32) {
            const int t = t0 + F.tid; const LAS float* f = fin + F.tid * 40;
            const float rs = 1.0f / sqrtf(f[36] * (1.f / DM) + EPS);
            float gl[4];
#pragma unroll
            for (int g = 0; g < 4; ++g) gl[g] = f[32 + g] * rs + bg[g];
            int gsel = 0; float gmax = gl[0];
#pragma unroll
            for (int g = 1; g < 4; ++g) if (gl[g] > gmax) { gmax = gl[g]; gsel = g; }
            float gsum = 0.f;
#pragma unroll
            for (int g = 0; g < 4; ++g) gsum += __expf(gl[g] - gmax);
            const float pg = 1.f / gsum;
            float el[8];
#pragma unroll
            for (int j = 0; j < 8; ++j) el[j] = f[gsel * 8 + j] * rs + br[gsel * 8 + j];
            int i0 = 0; float v0 = el[0];
#pragma unroll
            for (int j = 1; j < 8; ++j) if (el[j] > v0) { v0 = el[j]; i0 = j; }
            int i1 = -1; float v1 = -INFINITY;
#pragma unroll
            for (int j = 0; j < 8; ++j) if (j != i0 && el[j] > v1) { v1 = el[j]; i1 = j; }
            const float ex = __expf(v1 - v0); const float w0 = pg / (1.f + ex), w1 = pg * ex / (1.f + ex);
            if (commit) {
                RS[t] = rs;
                const int e0 = gsel * 8 + i0, e1 = gsel * 8 + i1;
                const unsigned p0 = atomicAdd(cnt + e0, 1u); LIST[e0 * T_TOK + p0] = 2 * t; WTOP[2 * t] = w0;
                const unsigned p1 = atomicAdd(cnt + e1, 1u); LIST[e1 * T_TOK + p1] = 2 * t + 1; WTOP[2 * t + 1] = w1;
            }
        }
        __syncthreads();
    }
}

__device__ __forceinline__ void p6_gather(Frame& F, const Args& a) {
    unsigned char* ws = a.ws;
    const float* H1 = a.out; const float* gm = a.in[I_NORM_MOE]; const float* RS = (const float*)(ws + WS_RS);
    bf16* XS = (bf16*)(ws + WS_XS); const int* LIST = (const int*)(ws + WS_LIST); int* ROWTOK = (int*)(ws + WS_ROWTOK);
    unsigned* cnt = (unsigned*)(ws + WS_CTL) + CW_CNT;
    volatile LAS int* toff = (volatile LAS int*)(F.MISC + 16);
    volatile LAS int* ecnt = (volatile LAS int*)(F.MISC + 56);
    volatile LAS int* t2e = (volatile LAS int*)(F.MISC + 96);
    if (F.tid == 0) { int acc = 0; for (int e = 0; e < NE; ++e) { const int c = (int)__hip_atomic_load(cnt + e, RLX_AGENT); toff[e] = acc; ecnt[e] = c; acc += (c + 255) >> 8; } toff[NE] = acc; }
    __syncthreads();
    const int ntile = toff[NE];
    if (F.tid < 96) { int e = 0; for (int j = 1; j < NE; ++j) if (toff[j] <= F.tid) e = j; t2e[F.tid] = e; }
    __syncthreads();
    const int gw = F.vcu * NWAVES + F.wave, NGW = F.G * NWAVES, lane = launder_v(F.lane), nrow = ntile * 256;
    f32x4 gg[8];
#pragma unroll
    for (int j = 0; j < 8; ++j) gg[j] = ((const f32x4*)gm)[lane + 64 * j];
    for (int r0 = gw; r0 < nrow; r0 += 2 * NGW) {
        int tk[2]; float rs[2]; f32x4 v[2][8];
#pragma unroll
        for (int q = 0; q < 2; ++q) { const int r = r0 + q * NGW; tk[q] = -1;
            if (r < nrow) { const int e = t2e[r >> 8], pos = r - toff[e] * 256; if (pos < ecnt[e]) tk[q] = LIST[e * T_TOK + pos]; } }
#pragma unroll
        for (int q = 0; q < 2; ++q) { const int tok = tk[q] >= 0 ? (tk[q] >> 1) : 0; rs[q] = RS[tok]; const f32x4* src = (const f32x4*)(H1 + (size_t)tok * DM) + lane;
#pragma unroll
            for (int j = 0; j < 8; ++j) v[q][j] = src[64 * j]; }
#pragma unroll
        for (int q = 0; q < 2; ++q) { const int r = r0 + q * NGW;
            if (r < nrow) { u32x2* dst = (u32x2*)(XS + (size_t)r * DM) + lane; const float sc = tk[q] >= 0 ? rs[q] : 0.f;
#pragma unroll
                for (int j = 0; j < 8; ++j) { u32x2 o; o.x = pk2(v[q][j].x * sc * gg[j].x, v[q][j].y * sc * gg[j].y); o.y = pk2(v[q][j].z * sc * gg[j].z, v[q][j].w * sc * gg[j].w); dst[64 * j] = o; }
                if (lane == 0) ROWTOK[r] = tk[q]; } }
    }
}

__device__ __forceinline__ void p9_rows(Frame& F, const Args& a) {
    unsigned char* ws = a.ws;
    float* H = a.out; const bf16* Y = (const bf16*)(ws + WS_R2); bf16* HN = (bf16*)(ws + WS_R1); const float* gp = a.in[I_NORM_PLE];
    const int gw = F.vcu * NWAVES + F.wave, NGW = F.G * NWAVES, lane = launder_v(F.lane);
    for (int t = gw; t < T_TOK; t += NGW) {
        f32x4* xr = (f32x4*)(H + (size_t)t * DM) + lane; const f32x4* gr = (const f32x4*)gp + lane;
        const u32x2* y0 = (const u32x2*)(Y + (size_t)(2 * t) * DM) + lane; const u32x2* y1 = (const u32x2*)(Y + (size_t)(2 * t + 1) * DM) + lane;
        f32x4 v[8]; float s = 0.f;
#pragma unroll
        for (int j = 0; j < 8; ++j) { v[j] = xr[64 * j]; const u32x2 a0 = y0[64 * j], a1 = y1[64 * j];
            v[j].x += bflo(a0.x) + bflo(a1.x); v[j].y += bfhi(a0.x) + bfhi(a1.x); v[j].z += bflo(a0.y) + bflo(a1.y); v[j].w += bfhi(a0.y) + bfhi(a1.y);
            xr[64 * j] = v[j]; s += (v[j].x * v[j].x + v[j].y * v[j].y) + (v[j].z * v[j].z + v[j].w * v[j].w); }
        const float rs = 1.0f / sqrtf(wave_sum(s) * (1.f / DM) + EPS);
        u32x2* o8 = (u32x2*)(HN + (size_t)t * DM) + lane;
#pragma unroll
        for (int j = 0; j < 8; ++j) { const f32x4 gg = gr[64 * j]; u32x2 w; w.x = pk2(v[j].x * rs * gg.x, v[j].y * rs * gg.y); w.y = pk2(v[j].z * rs * gg.z, v[j].w * rs * gg.w); o8[64 * j] = w; }
    }
}

#ifndef PHASE_MASK
#define PHASE_MASK 0xFFFF
#endif
#define PHASE_ON(k) (((PHASE_MASK) >> (k)) & 1)
#ifndef DUP_MASK
#define DUP_MASK 0
#endif
#define NREP(k) (PHASE_ON(k) ? 1 + (((DUP_MASK) >> (k)) & 1) : 0)

template <class Epi, class Sched>
__device__ __forceinline__ void run_gemm(LAS unsigned char* lds, const pg8::Gemm g, const Sched& S, const Epi& E) {
#if USE_PG8
    pg8::gemm_phase<Epi, Sched, false, true>(lds, g, S, E);
#else
    pg8::gemm_simple<Epi, Sched>(g, S, E);
    __syncthreads();
#endif
}

__global__ void __launch_bounds__(NWAVES * 64, 2) mega_fwd(Args args) {
    extern __shared__ __attribute__((aligned(16))) unsigned char lds[];
    Frame F;
    F.lds = (LAS unsigned char*)lds;
    F.MISC = (volatile LAS unsigned*)(F.lds + MISC_OFF);
    F.tid = threadIdx.x; F.lane = F.tid & 63; F.wave = __builtin_amdgcn_readfirstlane(F.tid >> 6);
    F.G = gridDim.x; { const int bx = blockIdx.x; F.vcu = (F.G % 8 == 0) ? (bx % 8) * (F.G / 8) + bx / 8 : bx; }
    unsigned char* ws = args.ws;
    F.ctl = (gu32*)(ws + WS_CTL);
    for (int u = F.tid; u < (LDS_BYTES - LDSCTL_OFF) / 4; u += NWAVES * 64) ((LAS unsigned*)(F.lds + LDSCTL_OFF))[u] = 0u;
    __syncthreads();
    XcdBarrier bar = xcd_barrier_post((unsigned*)(F.ctl + CW_BAR), F.MISC + 8);
#define GRID_BAR() xcd_barrier(bar)
    const int G = F.G, bx = (int)blockIdx.x;

    for (int rep = 0; rep < NREP(0); ++rep) {
    p0_prologue(F, args);
    GRID_BAR();

    }
    for (int rep = 0; rep < NREP(1); ++rep) {
    {
        pg8::Gemm g{(const bf16*)(ws + WS_R1), (const bf16*)(ws + WS_WIN), T_TOK, DINP, DM}; pg8::StaticOrder S; S.init(T_TOK, DINP, G, bx);
        EpiBf16Plain E{(bf16*)(ws + WS_R2), DINP};
        run_gemm(F.lds + RING_OFF, g, S, E);
    }
    {
        pg8::Gemm g{(const bf16*)(ws + WS_PB), (const bf16*)(ws + WS_WPLE), T_TOK, DM, PLE}; pg8::StaticOrder S; S.init(T_TOK, DM, G, bx);
        EpiBf16Plain E{(bf16*)(ws + WS_PE), DM};
        run_gemm(F.lds + RING_OFF, g, S, E);
    }
    GRID_BAR();

    }
    for (int rep = 0; rep < NREP(2); ++rep) {
    p2a_rows(F, args);
    GRID_BAR();

    }
    for (int rep = 0; rep < NREP(3); ++rep) {
    {
        pg8::Gemm g{(const bf16*)(ws + WS_QLN), (const bf16*)(ws + WS_WUQ), T_TOK, DM, QR}; pg8::StaticOrder S; S.init(T_TOK, DM, G, bx);
        EpiBf16Plain E{(bf16*)(ws + WS_R1), DM};
        run_gemm(F.lds + RING_OFF, g, S, E);
    }
    {
        pg8::Gemm g{(const bf16*)(ws + WS_KVLN), (const bf16*)(ws + WS_WUKV), T_TOK, DM, KVR}; pg8::StaticOrder S; S.init(T_TOK, DM, G, bx);
        EpiBf16Plain E{(bf16*)(ws + WS_KVRAW), DM};
        run_gemm(F.lds + RING_OFF, g, S, E);
    }
    GRID_BAR();

    }
    for (int rep = 0; rep < NREP(4); ++rep) {
    p2c_k(F, args);
    GRID_BAR();

    }
    for (int rep = 0; rep < NREP(5); ++rep) {
    {
        const bf16* QRAW = (const bf16*)(ws + WS_R1); const bf16* K = (const bf16*)(ws + WS_K); const bf16* KVRAW = (const bf16*)(ws + WS_KVRAW); bf16* O = (bf16*)(ws + WS_R2);
        const float* CS = (const float*)(ws + WS_CS);
        for (int u = F.vcu; u < 256; u += G) {
            const int bh = u >> 4, qb = u & 15, b = bh >> 3, h = bh & 7; const size_t t0 = (size_t)b * SEQ + qb * 256;
            att::attn_unit(QRAW + t0 * DM + h * 256, args.in[I_G_QHEAD], CS + t0 * 64, K + (size_t)bh * SEQ * QKH, KVRAW + (size_t)b * SEQ * DM + h * 256 + 128,
                           O + t0 * 1024 + h * 128, qb, (char*)lds + RING_OFF);
        }
        if (rep == 0) moe_convert_dyn(F, args);
    }
    GRID_BAR();

    }
    for (int rep = 0; rep < NREP(6); ++rep) {
    p3b_rows(F, args);
    GRID_BAR();

    }
    for (int rep = 0; rep < NREP(7); ++rep) {
    {
        pg8::Gemm g{(const bf16*)(ws + WS_R4), (const bf16*)(ws + WS_WOUT), T_TOK, DM, DM}; pg8::StaticOrder S; S.init(T_TOK, DM, G, bx);
        EpiResF32 E{args.in[I_X], args.out, DM};
        run_gemm(F.lds + RING_OFF, g, S, E);
    }
    GRID_BAR();

    }
    for (int rep = 0; rep < NREP(8); ++rep) {
    p5_route(F, args, rep == 0);
    GRID_BAR();

    }
    for (int rep = 0; rep < NREP(9); ++rep) {
    p6_gather(F, args);
    GRID_BAR();

    }
    for (int rep = 0; rep < NREP(10); ++rep) {
    {
        pg8::Gemm g{(const bf16*)(ws + WS_XS), (const bf16*)(ws + WS_W13), MAXROWS, 1024, DM};
        pg8::MoeOrder S{(const volatile LAS int*)(F.MISC + 16), 4, G, bx};
        EpiSwiGLU E{(bf16*)(ws + WS_R4)};
        run_gemm(F.lds + RING_OFF, g, S, E);
    }
    GRID_BAR();

    }
    for (int rep = 0; rep < NREP(11); ++rep) {
    {
        pg8::Gemm g{(const bf16*)(ws + WS_R4), (const bf16*)(ws + WS_W2), MAXROWS, DM, DE};
        pg8::MoeOrder S{(const volatile LAS int*)(F.MISC + 16), 8, G, bx};
        EpiMoeOut E{(bf16*)(ws + WS_R2), (const int*)(ws + WS_ROWTOK), (const float*)(ws + WS_WTOP)};
        run_gemm(F.lds + RING_OFF, g, S, E);
    }
    GRID_BAR();

    }
    for (int rep = 0; rep < NREP(12); ++rep) {
    p9_rows(F, args);
    GRID_BAR();

    }
    for (int rep = 0; rep < NREP(13); ++rep) {
    {
        pg8::Gemm g{(const bf16*)(ws + WS_R1), (const bf16*)(ws + WS_WPG), T_TOK, DM, DM}; pg8::StaticOrder S; S.init(T_TOK, DM, G, bx);
        EpiGate E{args.out, (const bf16*)(ws + WS_PE), args.in[I_B_PLE_GATE]};
        run_gemm(F.lds + RING_OFF, g, S, E);
    }
}
    }

extern "C" void kernel_launch(void* const* d_in, const int* in_sizes, int n_in, void* d_out, int out_size, void* d_ws, size_t ws_size, hipStream_t stream) {
    static int grid = 0;
    if (grid == 0) {
        if (n_in != 27 || out_size != T_TOK * DM || ws_size < WS_END) { fprintf(stderr, "kernel_launch: unexpected shapes: n_in %d out %d ws %zu (need %zu)\n", n_in, out_size, ws_size, (size_t)WS_END); grid = -1; return; }
        int dev = 0, cus = 0, per_cu = 0;
        if (hipGetDevice(&dev) != hipSuccess || hipDeviceGetAttribute(&cus, hipDeviceAttributeMultiprocessorCount, dev) != hipSuccess) { grid = -1; return; }
        if (hipFuncSetAttribute((const void*)mega_fwd, hipFuncAttributeMaxDynamicSharedMemorySize, LDS_BYTES) != hipSuccess) { fprintf(stderr, "kernel_launch: hipFuncSetAttribute failed\n"); grid = -1; return; }
        if (hipOccupancyMaxActiveBlocksPerMultiprocessor(&per_cu, (const void*)mega_fwd, NWAVES * 64, LDS_BYTES) != hipSuccess || per_cu < 1)
            fprintf(stderr, "kernel_launch: note: occupancy query reports %d\n", per_cu);
        (void)hipGetLastError();
        grid = cus;
    }
    if (grid < 0) return;
    if (hipMemsetAsync((char*)d_ws + WS_CTL, 0, CTL_ZERO_BYTES, stream) != hipSuccess) { fprintf(stderr, "kernel_launch: memset failed\n"); return; }
    Args a{};
    for (int i = 0; i < 27; ++i) a.in[i] = (const float*)d_in[i];
    a.out = (float*)d_out; a.ws = (unsigned char*)d_ws;
    for (int i = 0; i < 32; ++i) a.freq[i] = powf(10000.0f, -(float)(2 * i) / 64.0f);
    hipLaunchKernelGGL(mega_fwd, dim3(grid), dim3(NWAVES * 64), LDS_BYTES, stream, a);
    const hipError_t le = hipPeekAtLastError();
    if (le != hipSuccess) fprintf(stderr, "kernel_launch: launch failed: %s\n", hipGetErrorName(le));
}
```
